# Optimizing an MI355X kernel written in HIP

```python
import jax, jax.numpy as jnp
from jax import lax
import numpy as np

D_MODEL = 2048
BATCH = 4
SEQ = 4096
DEPTH = 2

N_A_LAYERS = max(1, DEPTH // 2)
N_B_LAYERS = DEPTH - N_A_LAYERS

HGRN_EXPAND = 128
HGRN_HEADS = D_MODEL // HGRN_EXPAND
HGRN_HEAD_V = D_MODEL // HGRN_HEADS
HGRN_CHUNK = 32

HEAD_DIM = 64
N_Q_HEADS = D_MODEL // HEAD_DIM
N_KV_HEADS = N_Q_HEADS // 8
GROUP = N_Q_HEADS // N_KV_HEADS
WINDOW = 128
ROT_DIM = HEAD_DIM // 4
ROPE_THETA = 500000.0

D_FF = 5504
N_SUBLAYERS = 3
NORM_EPS = 1e-6
NEG_INF = -1e30

kernel_name = "yoco_hgrn2_swa_sink_macaron_adaln"


def rmsnorm(x, gain):
    xf = x.astype(jnp.float32)
    y = xf * lax.rsqrt(jnp.mean(xf * xf, axis=-1, keepdims=True) + NORM_EPS)
    return (y * gain.astype(jnp.float32)).astype(x.dtype)


def ada_norm(h, gain, shift, scale):
    return rmsnorm(h, gain) * (1.0 + scale[:, None, :]) + shift[:, None, :]


def swiglu(u, w_in, w_out):
    a, b = jnp.split(u @ w_in, 2, axis=-1)
    return (jax.nn.silu(a) * b) @ w_out


def rope_tables(seq):
    inv_freq = jnp.power(jnp.float32(ROPE_THETA), -jnp.arange(0, ROT_DIM, 2, dtype=jnp.float32) / ROT_DIM)
    ang = jnp.arange(seq, dtype=jnp.float32)[:, None] * inv_freq[None, :]
    return jnp.sin(ang), jnp.cos(ang)


def partial_rotary(t, sin, cos):
    half = ROT_DIM // 2
    s = sin[None, :, None, :].astype(t.dtype)
    c = cos[None, :, None, :].astype(t.dtype)
    t1, t2, rest = t[..., :half], t[..., half:ROT_DIM], t[..., ROT_DIM:]
    return jnp.concatenate([t1 * c - t2 * s, t2 * c + t1 * s, rest], axis=-1)


def hgrn2_chunk_scan(q, k, v, log_f):
    B, S, H, K = q.shape
    V = v.shape[-1]
    nc = S // HGRN_CHUNK

    def to_chunks(t):
        return t.reshape(B, nc, HGRN_CHUNK, H, t.shape[-1]).transpose(1, 0, 3, 2, 4)

    causal = jnp.tril(jnp.ones((HGRN_CHUNK, HGRN_CHUNK), dtype=bool))

    def step(state, inp):
        qc, kc, vc, gc = inp
        b = jnp.cumsum(gc, axis=2)
        inter = jnp.einsum('bhck,bhkv->bhcv', qc * jnp.exp(b), state)
        rel = b[:, :, :, None, :] - b[:, :, None, :, :]
        decay = jnp.exp(jnp.where(causal[None, None, :, :, None], rel, -jnp.inf))
        scores = jnp.einsum('bhtk,bhsk,bhtsk->bhts', qc, kc, decay)
        out = inter + jnp.einsum('bhts,bhsv->bhtv', scores, vc)
        b_last = b[:, :, -1, :]
        k_dec = kc * jnp.exp(b_last[:, :, None, :] - b)
        new_state = jnp.exp(b_last)[..., None] * state + jnp.einsum('bhck,bhcv->bhkv', k_dec, vc)
        return new_state, out

    state0 = jnp.zeros((B, H, K, V), jnp.float32)
    _, outs = lax.scan(step, state0, (to_chunks(q), to_chunks(k), to_chunks(v), to_chunks(log_f)))
    return outs.transpose(1, 0, 3, 2, 4).reshape(B, S, H, V)


def hgrn2_mixer(u, w_in, lower_bound, head_gain, w_out):
    B, S, _ = u.shape
    q, f, i, g = jnp.split(u @ w_in, 4, axis=-1)
    forget = lower_bound + (1.0 - lower_bound) * jax.nn.sigmoid(f.astype(jnp.float32))

    def heads(t):
        return t.reshape(B, S, HGRN_HEADS, -1)

    o = hgrn2_chunk_scan(heads(jax.nn.silu(q).astype(jnp.float32)),
                         heads(1.0 - forget),
                         heads(i.astype(jnp.float32)),
                         heads(jnp.log(forget)))
    o = rmsnorm(o, head_gain.reshape(HGRN_HEADS, HGRN_HEAD_V)).astype(u.dtype)
    o = o.reshape(B, S, D_MODEL) * jax.nn.sigmoid(g)
    return o @ w_out


def shared_kv(h, cs, kv_gain, w_ada_kv, b_ada_kv, w_kv, b_kv, sin, cos):
    B, S, _ = h.shape
    shift, scale = jnp.split(cs @ w_ada_kv + b_ada_kv, 2, axis=-1)
    u = ada_norm(h, kv_gain, shift, scale)
    k, v = jnp.split(u @ w_kv + b_kv, 2, axis=-1)
    k = partial_rotary(k.reshape(B, S, N_KV_HEADS, HEAD_DIM), sin, cos)
    v = v.reshape(B, S, N_KV_HEADS, HEAD_DIM)
    return k, v


def sliding_window_attention(q, k, v, sinks):
    B, S, _, Dh = q.shape
    nb = S // WINDOW
    qb = q.reshape(B, nb, WINDOW, N_KV_HEADS, GROUP, Dh)

    def band(t):
        tb = t.reshape(B, nb, WINDOW, N_KV_HEADS, Dh)
        prev = jnp.pad(tb, ((0, 0), (1, 0), (0, 0), (0, 0), (0, 0)))[:, :nb]
        return jnp.concatenate([prev, tb], axis=2)

    kb, vb = band(k), band(v)
    scores = jnp.einsum('bnqhgd,bnkhd->bnhgqk', qb, kb).astype(jnp.float32) * (Dh ** -0.5)
    qi = jnp.arange(WINDOW)[:, None]
    kj = jnp.arange(2 * WINDOW)[None, :]
    in_window = (kj > qi) & (kj <= qi + WINDOW)
    not_before_start = (jnp.arange(nb)[:, None, None] > 0) | (kj[None] >= WINDOW)
    mask = in_window[None] & not_before_start
    scores = jnp.where(mask[None, :, None, None], scores, NEG_INF)
    sink = sinks.astype(jnp.float32).reshape(N_KV_HEADS, GROUP)[None, None, :, :, None, None]
    m = jnp.maximum(jnp.max(scores, axis=-1, keepdims=True), sink)
    p = jnp.exp(scores - m)
    probs = p / (jnp.sum(p, axis=-1, keepdims=True) + jnp.exp(sink - m))
    out = jnp.einsum('bnhgqk,bnkhd->bnqhgd', probs.astype(v.dtype), vb)
    return out.reshape(B, S, N_Q_HEADS * Dh)


def setup_inputs(seed: int = 0) -> dict:
    key = jax.random.key(seed)
    ks = jax.random.split(key, 22)
    f32 = jnp.float32

    def w(k, shape, fan_in, scale=1.0):
        return jax.random.normal(k, shape, f32) * (scale * fan_in ** -0.5)

    def gain(k, shape):
        return 1.0 + 0.02 * jax.random.normal(k, shape, f32)

    qdim = N_Q_HEADS * HEAD_DIM
    kvdim = 2 * N_KV_HEADS * HEAD_DIM
    return {
        "x": jax.random.normal(ks[0], (BATCH, SEQ, D_MODEL), f32),
        "c": jax.random.normal(ks[1], (BATCH, D_MODEL), f32),
        "norm_gain": gain(ks[2], (DEPTH, N_SUBLAYERS, D_MODEL)),
        "w_ada": w(ks[3], (DEPTH, D_MODEL, N_SUBLAYERS * 3 * D_MODEL), D_MODEL, 0.5),
        "b_ada": 0.02 * jax.random.normal(ks[4], (DEPTH, N_SUBLAYERS * 3 * D_MODEL), f32),
        "w_ffn_in": w(ks[5], (DEPTH, 2, D_MODEL, 2 * D_FF), D_MODEL),
        "w_ffn_out": w(ks[6], (DEPTH, 2, D_FF, D_MODEL), D_FF),
        "w_hgrn_in": w(ks[7], (N_A_LAYERS, D_MODEL, 4 * D_MODEL), D_MODEL),
        "hgrn_lb_logits": 0.5 * jax.random.normal(ks[8], (N_A_LAYERS + 1, D_MODEL), f32),
        "hgrn_head_gain": gain(ks[9], (N_A_LAYERS, D_MODEL)),
        "w_hgrn_out": w(ks[10], (N_A_LAYERS, D_MODEL, D_MODEL), D_MODEL),
        "kv_gain": gain(ks[11], (D_MODEL,)),
        "w_ada_kv": w(ks[12], (D_MODEL, 2 * D_MODEL), D_MODEL, 0.5),
        "b_ada_kv": 0.02 * jax.random.normal(ks[13], (2 * D_MODEL,), f32),
        "w_kv": w(ks[14], (D_MODEL, kvdim), D_MODEL),
        "b_kv": 0.02 * jax.random.normal(ks[15], (kvdim,), f32),
        "w_q": w(ks[16], (N_B_LAYERS, D_MODEL, qdim), D_MODEL),
        "b_q": 0.02 * jax.random.normal(ks[17], (N_B_LAYERS, qdim), f32),
        "attn_sinks": jax.random.normal(ks[18], (N_B_LAYERS, N_Q_HEADS), f32),
        "w_attn_out": w(ks[19], (N_B_LAYERS, qdim, D_MODEL), qdim),
        "final_gain": gain(ks[20], (D_MODEL,)),
    }


def reference(x, c, norm_gain, w_ada, b_ada, w_ffn_in, w_ffn_out, w_hgrn_in, hgrn_lb_logits,
              hgrn_head_gain, w_hgrn_out, kv_gain, w_ada_kv, b_ada_kv, w_kv, b_kv, w_q, b_q,
              attn_sinks, w_attn_out, final_gain):
    B, S, D = x.shape
    sin, cos = rope_tables(S)
    lb_all = jnp.cumsum(jax.nn.softmax(hgrn_lb_logits.astype(jnp.float32), axis=0), axis=0)
    cs = jax.nn.silu(c)
    h = x
    k_sh, v_sh = None, None
    for layer in range(DEPTH):
        mod = (cs @ w_ada[layer] + b_ada[layer]).reshape(B, N_SUBLAYERS, 3, D)

        u = ada_norm(h, norm_gain[layer, 0], mod[:, 0, 0], mod[:, 0, 1])
        h = h + 0.5 * mod[:, 0, 2][:, None, :] * swiglu(u, w_ffn_in[layer, 0], w_ffn_out[layer, 0])

        u = ada_norm(h, norm_gain[layer, 1], mod[:, 1, 0], mod[:, 1, 1])
        if layer < N_A_LAYERS:
            y = hgrn2_mixer(u, w_hgrn_in[layer], lb_all[layer], hgrn_head_gain[layer], w_hgrn_out[layer])
        else:
            bl = layer - N_A_LAYERS
            q = (u @ w_q[bl] + b_q[bl]).reshape(B, S, N_Q_HEADS, HEAD_DIM)
            q = partial_rotary(q, sin, cos)
            y = sliding_window_attention(q, k_sh, v_sh, attn_sinks[bl]) @ w_attn_out[bl]
        h = h + mod[:, 1, 2][:, None, :] * y

        u = ada_norm(h, norm_gain[layer, 2], mod[:, 2, 0], mod[:, 2, 1])
        h = h + 0.5 * mod[:, 2, 2][:, None, :] * swiglu(u, w_ffn_in[layer, 1], w_ffn_out[layer, 1])

        if layer == N_A_LAYERS - 1:
            k_sh, v_sh = shared_kv(h, cs, kv_gain, w_ada_kv, b_ada_kv, w_kv, b_kv, sin, cos)

    return rmsnorm(h, final_gain)
```

```cpp
#include <hip/hip_runtime.h>
#include <cstdio>
#include <cstdint>
namespace pg8 {
#define PG8_LAS __attribute__((address_space(3)))
typedef unsigned short bf16_t;
typedef short bf16x8 __attribute__((ext_vector_type(8)));
typedef float f32x4 __attribute__((ext_vector_type(4)));
typedef unsigned u32x4 __attribute__((ext_vector_type(4)));
constexpr int BM = 256, BK = 64, HALF = 128, HTB = HALF * BK * 2  , STAGE_BYTES = 8 * HTB, NXCD = 8, WGM = 8;

__host__ __device__ __forceinline__ int lds_byte(int r, int c) { const int st = (r >> 4) * 2 + (c >> 5), rr = r & 15, cc = c & 31, ob = rr * 64 + cc * 2; return st * 1024 + (ob ^ (((ob >> 9) & 1) << 5)); }
__host__ __device__ __forceinline__ void stage_rc(int b, int& R, int& C) { const int st = b / 1024, sb = b % 1024, swz = sb ^ (((sb >> 9) & 1) << 5); R = (st >> 1) * 16 + swz / 64; C = (st & 1) * 32 + (swz % 64) / 2; }
__host__ __device__ __forceinline__ int perm32(int rho) { const int n = rho >> 4, i = rho & 15; return 8 * (i >> 2) + 4 * n + (i & 3); }

struct Unit { int pm, pn; };
struct Gemm { const bf16_t* A; const bf16_t* Bt; int M, N, K; int rsA, ksA, rsB, ksB; int opmask; };

struct StaticOrder {
    int nM, nN, nwg, G, c;
    __host__ __device__ void init(int M, int N, int G_, int c_) { nM = M / BM; nN = N / BM; nwg = nM * nN; G = G_; c = c_; }
    __host__ __device__ bool next(int i, Unit& u) const {
        const long L = (long)i * G + c; if (L >= nwg) return false;
        int wgid = (int)L; { const int q = nwg / NXCD, r = nwg % NXCD, xcd = wgid % NXCD, off = wgid / NXCD; wgid = (xcd < r ? xcd * (q + 1) : r * (q + 1) + (xcd - r) * q) + off; }
        const int nig = WGM * nN, gid = wgid / nig, fm = gid * WGM, gsz = (nM - fm) < WGM ? (nM - fm) : WGM;
        u.pm = fm + ((wgid % nig) % gsz); u.pn = (wgid % nig) / gsz; return true;
    }
    __device__ __forceinline__ void a_ready(const Unit&) const {}
    __device__ __forceinline__ void done(const Unit&) const {}
};
__device__ __forceinline__ unsigned cvt_pk_bf16(float lo, float hi) { unsigned r; asm volatile("v_cvt_pk_bf16_f32 %0, %1, %2" : "=v"(r) : "v"(lo), "v"(hi)); return r; }
typedef float f32x2 __attribute__((ext_vector_type(2)));
typedef _Float16 f16x2 __attribute__((ext_vector_type(2)));
__device__ __forceinline__ unsigned cvt_pk_f16(float lo, float hi) { f16x2 v = {(_Float16)lo, (_Float16)hi}; return __builtin_bit_cast(unsigned, v); }
__device__ __forceinline__ float fsigmoid(float x) { return __builtin_amdgcn_rcpf(1.f + __builtin_amdgcn_exp2f(-1.4426950408889634f * x)); }
constexpr int SEQ_ROWS = 4096;


struct NormFix { const float* rowss; const float* sw; int swstride; float invk, eps; };
constexpr int NFX_OFF = STAGE_BYTES + 1024, NFX_BUF = 2048;
__device__ __forceinline__ void normfix_prefetch(const NormFix& nf, PG8_LAS unsigned char* lds, const Unit& u, int par, int wid, int lane) {
    const int b = (u.pm * BM) / SEQ_ROWS;
    const float* gp = (wid < 4) ? nf.rowss + u.pm * BM + 64 * wid + lane : nf.sw + (size_t)b * nf.swstride + u.pn * BM + 64 * (wid - 4) + lane;
    __builtin_amdgcn_global_load_lds((const unsigned*)gp, (PG8_LAS unsigned*)(lds + NFX_OFF + par * NFX_BUF + 256 * wid), 4, 0, 0);
}
__device__ __forceinline__ void normfix_rstd(const NormFix& nf, const PG8_LAS unsigned char* lds, int par, int rloc0, float (&rs)[2][4]) {
    const PG8_LAS float* r = (const PG8_LAS float*)(lds + NFX_OFF + par * NFX_BUF);
#pragma unroll
    for (int ai = 0; ai < 2; ++ai)
#pragma unroll
        for (int m = 0; m < 4; ++m) rs[ai][m] = 1.0f / sqrtf(r[rloc0 + ai * HALF + m * 16] * nf.invk + nf.eps);
}
__device__ __forceinline__ f32x4 normfix_sw(const PG8_LAS unsigned char* lds, int par, int cloc) { return *(const PG8_LAS f32x4*)(lds + NFX_OFF + par * NFX_BUF + 1024 + 4 * cloc); }

template <bool FUSED> struct EpiSwiGLU {
    static constexpr bool PERM = true, AFTER_DRAIN = false;
    bf16_t* O; int rows;
    NormFix nf;
    __device__ __forceinline__ void prefetch(PG8_LAS unsigned char* lds, const Unit& u, int par, int wid, int lane) const { if (FUSED) normfix_prefetch(nf, lds, u, par, wid, lane); }
    __device__ __forceinline__ void operator()(const f32x4 (&acc)[2][2][4][2], const Unit& u, int wr, int wc, int fr, int fq, const PG8_LAS unsigned char* lds, int par) const {
        const int row0 = u.pm * BM + wr * 64 + fr, kb = 2 * u.pn + (wc >> 1), within = 32 * (wc & 1) + 8 * fq;
        float rs[2][4]; f32x4 swv[2][2];
        if (FUSED) { normfix_rstd(nf, lds, par, wr * 64 + fr, rs);
#pragma unroll
            for (int bj = 0; bj < 2; ++bj)
#pragma unroll
                for (int n = 0; n < 2; ++n) swv[bj][n] = normfix_sw(lds, par, wc * 32 + 8 * fq + bj * HALF + 4 * n); }
#pragma unroll
        for (int ai = 0; ai < 2; ++ai)
#pragma unroll
            for (int m = 0; m < 4; ++m) { bf16_t* rowp = O + ((size_t)kb * rows + (row0 + ai * HALF + m * 16)) * 64 + within;
                f32x4 a0 = acc[ai][0][m][0], a1 = acc[ai][0][m][1], b0 = acc[ai][1][m][0], b1 = acc[ai][1][m][1]; f32x4 v0, v1;
                if (FUSED) { const float r = rs[ai][m]; a0 = a0 * r + swv[0][0]; a1 = a1 * r + swv[0][1]; b0 = b0 * r + swv[1][0]; b1 = b1 * r + swv[1][1]; }
                { f32x4 e0, e1;
#pragma unroll
                  for (int j = 0; j < 4; ++j) { e0[j] = __builtin_amdgcn_exp2f(a0[j]); e1[j] = __builtin_amdgcn_exp2f(a1[j]); }
                  e0 = e0 + 1.0f; e1 = e1 + 1.0f;
#pragma unroll
                  for (int j = 0; j < 4; ++j) { e0[j] = __builtin_amdgcn_rcpf(e0[j]); e1[j] = __builtin_amdgcn_rcpf(e1[j]); }
                  v0 = (a0 * b0) * e0; v1 = (a1 * b1) * e1; }
                u32x4 w; w.x = cvt_pk_bf16(v0[0], v0[1]); w.y = cvt_pk_bf16(v0[2], v0[3]); w.z = cvt_pk_bf16(v1[0], v1[1]); w.w = cvt_pk_bf16(v1[2], v1[3]);
                *(__attribute__((address_space(1))) u32x4*)rowp = w; }
    }
};
template <int NOUT, bool HALFSTEP> struct EpiResid {
    static constexpr bool PERM = false, AFTER_DRAIN = false;
    const float* src; float* dst; int ld; const float* gate; int gstride;
    bf16_t* A1; const float* g1p; const float* sc1p; int st1; bf16_t* A2; const float* g2p; const float* sc2p; int st2; float* rowss;
    __device__ __forceinline__ void prefetch(PG8_LAS unsigned char*, const Unit&, int, int, int) const {}
    __device__ __forceinline__ void operator()(const f32x4 (&acc)[2][2][4][2], const Unit& u, int, int, int, int, const PG8_LAS unsigned char*, int) const {
        int tz = threadIdx.x; asm volatile("" : "+v"(tz));
        const int wid = tz >> 6, lane = tz & 63, wr = wid >> 2, wc = wid & 3, fr = lane & 15, fq = lane >> 4;
        const int row0 = u.pm * BM + wr * 64 + fr, col0 = u.pn * BM + wc * 32 + 4 * fq, b = (u.pm * BM) / SEQ_ROWS;
        f32x4 gv[2][2], g1[2][2], g2[2][2];
#pragma unroll
        for (int bj = 0; bj < 2; ++bj)
#pragma unroll
            for (int n = 0; n < 2; ++n) { const int c = col0 + bj * HALF + n * 16; gv[bj][n] = *(const __attribute__((address_space(1))) f32x4*)(gate + (size_t)b * gstride + c) * (HALFSTEP ? 0.5f : 1.0f);
                if (NOUT >= 1) g1[bj][n] = *(const f32x4*)(g1p + c) * (*(const f32x4*)(sc1p + (size_t)b * st1 + c) + 1.0f);
                if (NOUT >= 2) g2[bj][n] = *(const f32x4*)(g2p + c) * (*(const f32x4*)(sc2p + (size_t)b * st2 + c) + 1.0f); }
        constexpr int MB = (NOUT == 0) ? 4 : (NOUT == 1 ? 2 : 1);
#pragma unroll
        for (int ai = 0; ai < 2; ++ai)
#pragma unroll
        for (int m0 = 0; m0 < 4; m0 += MB) {
            f32x4 s[MB][2][2];
#pragma unroll
            for (int mm = 0; mm < MB; ++mm) { const size_t off = (size_t)(row0 + ai * HALF + (m0 + mm) * 16) * ld + col0;
#pragma unroll
                for (int bj = 0; bj < 2; ++bj)
#pragma unroll
                    for (int n = 0; n < 2; ++n) s[mm][bj][n] = *(const f32x4*)(src + off + bj * HALF + n * 16); }
#pragma unroll
            for (int mm = 0; mm < MB; ++mm) { const int m = m0 + mm, row = row0 + ai * HALF + m * 16; const size_t off = (size_t)row * ld + col0; float ss = 0.f;
#pragma unroll
                for (int bj = 0; bj < 2; ++bj)
#pragma unroll
                    for (int n = 0; n < 2; ++n) { const f32x4 hn = s[mm][bj][n] + gv[bj][n] * acc[ai][bj][m][n]; *(f32x4*)(dst + off + bj * HALF + n * 16) = hn;
                        if (NOUT >= 1) { ss += (hn.x * hn.x + hn.y * hn.y) + (hn.z * hn.z + hn.w * hn.w); const f32x4 y = hn * g1[bj][n];
                            typedef unsigned u32x2 __attribute__((ext_vector_type(2))); u32x2 w; w.x = cvt_pk_bf16(y.x, y.y); w.y = cvt_pk_bf16(y.z, y.w); *(u32x2*)(A1 + off + bj * HALF + n * 16) = w; }
                        if (NOUT >= 2) { const f32x4 y = hn * g2[bj][n];
                            typedef unsigned u32x2 __attribute__((ext_vector_type(2))); u32x2 w; w.x = cvt_pk_bf16(y.x, y.y); w.y = cvt_pk_bf16(y.z, y.w); *(u32x2*)(A2 + off + bj * HALF + n * 16) = w; } }
                if (NOUT >= 1) { ss += __shfl_xor(ss, 16); ss += __shfl_xor(ss, 32);
                    if (fq == 0) (void)__hip_atomic_fetch_add(rowss + row, ss, __ATOMIC_RELAXED, __HIP_MEMORY_SCOPE_AGENT); } }
        }
    }
};
template <bool HALFSTEP> struct EpiY {
    static constexpr bool PERM = true, AFTER_DRAIN = false;
    bf16_t* Y; int ld; const float* gate; int gstride;
    __device__ __forceinline__ void prefetch(PG8_LAS unsigned char*, const Unit&, int, int, int) const {}
    __device__ __forceinline__ void operator()(const f32x4 (&acc)[2][2][4][2], const Unit& u, int wr, int wc, int fr, int fq, const PG8_LAS unsigned char*, int) const {
        const int row0 = u.pm * BM + wr * 64 + fr, col0 = u.pn * BM + wc * 32 + 8 * fq, b = (u.pm * BM) / SEQ_ROWS;
        f32x4 gv[2][2];
#pragma unroll
        for (int bj = 0; bj < 2; ++bj)
#pragma unroll
            for (int n = 0; n < 2; ++n) gv[bj][n] = *(const __attribute__((address_space(1))) f32x4*)(gate + (size_t)b * gstride + col0 + bj * HALF + 4 * n) * (HALFSTEP ? 0.5f : 1.0f);
#pragma unroll
        for (int ai = 0; ai < 2; ++ai)
#pragma unroll
            for (int m = 0; m < 4; ++m) { bf16_t* rowp = Y + (size_t)(row0 + ai * HALF + m * 16) * ld + col0;
#pragma unroll
                for (int bj = 0; bj < 2; ++bj) { const f32x4 v0 = acc[ai][bj][m][0] * gv[bj][0], v1 = acc[ai][bj][m][1] * gv[bj][1];
                    u32x4 w; w.x = cvt_pk_f16(v0[0], v0[1]); w.y = cvt_pk_f16(v0[2], v0[3]); w.z = cvt_pk_f16(v1[0], v1[1]); w.w = cvt_pk_f16(v1[2], v1[3]);
                    *(__attribute__((address_space(1))) u32x4*)(rowp + bj * HALF) = w; } }
    }
};
template <bool HALFSTEP, bool SRC32> struct EpiYR {
    static constexpr bool PERM = true, AFTER_DRAIN = false;
    bf16_t* H; const float* X; int ld; const float* gate; int gstride;
    __device__ __forceinline__ void prefetch(PG8_LAS unsigned char*, const Unit&, int, int, int) const {}
    __device__ __forceinline__ void operator()(const f32x4 (&acc)[2][2][4][2], const Unit& u, int wr, int wc, int fr, int fq, const PG8_LAS unsigned char*, int) const {
        const int row0 = u.pm * BM + wr * 64 + fr, col0 = u.pn * BM + wc * 32 + 8 * fq, b = (u.pm * BM) / SEQ_ROWS;
        f32x4 gv[2][2];
#pragma unroll
        for (int bj = 0; bj < 2; ++bj)
#pragma unroll
            for (int n = 0; n < 2; ++n) gv[bj][n] = *(const __attribute__((address_space(1))) f32x4*)(gate + (size_t)b * gstride + col0 + bj * HALF + 4 * n) * (HALFSTEP ? 0.5f : 1.0f);
#pragma unroll
        for (int ai = 0; ai < 2; ++ai) {
            u32x4 r16[4][2]; f32x4 r32[4][2][2];
#pragma unroll
            for (int m = 0; m < 4; ++m)
#pragma unroll
                for (int bj = 0; bj < 2; ++bj) { const size_t off = (size_t)(row0 + ai * HALF + m * 16) * ld + col0 + bj * HALF;
                    if (SRC32) { r32[m][bj][0] = *(const __attribute__((address_space(1))) f32x4*)(X + off); r32[m][bj][1] = *(const __attribute__((address_space(1))) f32x4*)(X + off + 4); }
                    else r16[m][bj] = *(const __attribute__((address_space(1))) u32x4*)(H + off); }
#pragma unroll
            for (int m = 0; m < 4; ++m)
#pragma unroll
                for (int bj = 0; bj < 2; ++bj) { const size_t off = (size_t)(row0 + ai * HALF + m * 16) * ld + col0 + bj * HALF;
                    f32x4 h0, h1;
                    if (SRC32) { h0 = r32[m][bj][0]; h1 = r32[m][bj][1]; }
                    else { const unsigned d0 = r16[m][bj].x, d1 = r16[m][bj].y, d2 = r16[m][bj].z, d3 = r16[m][bj].w;
                        const f16x2 p0 = __builtin_bit_cast(f16x2, d0), p1 = __builtin_bit_cast(f16x2, d1), p2 = __builtin_bit_cast(f16x2, d2), p3 = __builtin_bit_cast(f16x2, d3);
                        h0[0] = (float)p0[0]; h0[1] = (float)p0[1]; h0[2] = (float)p1[0]; h0[3] = (float)p1[1]; h1[0] = (float)p2[0]; h1[1] = (float)p2[1]; h1[2] = (float)p3[0]; h1[3] = (float)p3[1]; }
                    const f32x4 v0 = h0 + acc[ai][bj][m][0] * gv[bj][0], v1 = h1 + acc[ai][bj][m][1] * gv[bj][1];
                    u32x4 w; w.x = cvt_pk_f16(v0[0], v0[1]); w.y = cvt_pk_f16(v0[2], v0[3]); w.z = cvt_pk_f16(v1[0], v1[1]); w.w = cvt_pk_f16(v1[2], v1[3]);
                    *(__attribute__((address_space(1))) u32x4*)(H + off) = w; }
        }
    }
};
template <bool FUSED> struct EpiHgrn {
    static constexpr bool PERM = true, AFTER_DRAIN = false;
    bf16_t* O; const float* lb; NormFix nf;
    __device__ __forceinline__ void prefetch(PG8_LAS unsigned char* lds, const Unit& u, int par, int wid, int lane) const { if (FUSED) normfix_prefetch(nf, lds, u, par, wid, lane); }
    __device__ __forceinline__ void operator()(const f32x4 (&acc)[2][2][4][2], const Unit& u, int wr, int wc, int fr, int fq, const PG8_LAS unsigned char* lds, int par) const {
        const int row0 = u.pm * BM + wr * 64 + fr, col0 = u.pn * BM + wc * 32 + 8 * fq, type = u.pn >> 3;
        float rs[2][4]; f32x4 swv[2][2];
        if (FUSED) { normfix_rstd(nf, lds, par, wr * 64 + fr, rs);
#pragma unroll
            for (int bj = 0; bj < 2; ++bj)
#pragma unroll
                for (int n = 0; n < 2; ++n) swv[bj][n] = normfix_sw(lds, par, wc * 32 + 8 * fq + bj * HALF + 4 * n); }
        f32x4 oml[2][2];
#pragma unroll
        for (int bj = 0; bj < 2; ++bj)
#pragma unroll
            for (int n = 0; n < 2; ++n) { oml[bj][n] = (f32x4){1.f, 1.f, 1.f, 1.f}; if (type == 1) oml[bj][n] = (f32x4){1.f, 1.f, 1.f, 1.f} - *(const __attribute__((address_space(1))) f32x4*)(lb + (col0 - 2048) + bj * HALF + 4 * n); }
#pragma unroll
        for (int ai = 0; ai < 2; ++ai)
#pragma unroll
            for (int m = 0; m < 4; ++m) { bf16_t* rowp = O + (size_t)(row0 + ai * HALF + m * 16) * 8192 + col0;
#pragma unroll
                for (int bj = 0; bj < 2; ++bj) { f32x4 v0 = acc[ai][bj][m][0], v1 = acc[ai][bj][m][1]; u32x4 w;
                    if (FUSED) { v0 = v0 * rs[ai][m] + swv[bj][0]; v1 = v1 * rs[ai][m] + swv[bj][1]; }
                    if (type == 0) {
#pragma unroll
                        for (int j = 0; j < 4; ++j) { v0[j] = v0[j] * fsigmoid(v0[j]); v1[j] = v1[j] * fsigmoid(v1[j]); } }
                    if (type == 1) {
#pragma unroll
                        for (int j = 0; j < 4; ++j) { v0[j] = oml[bj][0][j] * fsigmoid(-v0[j]); v1[j] = oml[bj][1][j] * fsigmoid(-v1[j]); } }
                    if (type == 3) {
#pragma unroll
                        for (int j = 0; j < 4; ++j) { v0[j] = fsigmoid(v0[j]); v1[j] = fsigmoid(v1[j]); } }
                    if (type == 1) { w.x = cvt_pk_f16(v0[0], v0[1]); w.y = cvt_pk_f16(v0[2], v0[3]); w.z = cvt_pk_f16(v1[0], v1[1]); w.w = cvt_pk_f16(v1[2], v1[3]); }
                    else { w.x = cvt_pk_bf16(v0[0], v0[1]); w.y = cvt_pk_bf16(v0[2], v0[3]); w.z = cvt_pk_bf16(v1[0], v1[1]); w.w = cvt_pk_bf16(v1[2], v1[3]); }
                    *(__attribute__((address_space(1))) u32x4*)(rowp + bj * HALF) = w; } }
    }
};
template <bool FUSED> struct EpiRope {
    static constexpr bool PERM = true, AFTER_DRAIN = false;
    bf16_t* O0; bf16_t* O1; int split, ldc; const float* bias; const float* sint; const float* cost; float scale; int rope_tiles; NormFix nf;
    __device__ __forceinline__ void prefetch(PG8_LAS unsigned char* lds, const Unit& u, int par, int wid, int lane) const { if (FUSED) normfix_prefetch(nf, lds, u, par, wid, lane); }
    __device__ __forceinline__ void operator()(const f32x4 (&acc)[2][2][4][2], const Unit& u, int wr, int wc, int fr, int fq, const PG8_LAS unsigned char* lds, int par) const {
        const int row0 = u.pm * BM + wr * 64 + fr; int colt = u.pn * BM; bf16_t* base = O0;
        if (colt >= split) { base = O1; colt -= split; }
        const int col0 = colt + wc * 32 + 8 * fq, bcol0 = u.pn * BM + wc * 32 + 8 * fq;
        const bool dorope = (u.pn < rope_tiles) && ((wc & 1) == 0);
        const float sgn = (fq == 0) ? -1.f : 1.f;
        f32x4 bv[2][2];
#pragma unroll
        for (int bj = 0; bj < 2; ++bj)
#pragma unroll
            for (int n = 0; n < 2; ++n) { bv[bj][n] = *(const __attribute__((address_space(1))) f32x4*)(bias + bcol0 + bj * HALF + 4 * n); if (FUSED) bv[bj][n] += normfix_sw(lds, par, wc * 32 + 8 * fq + bj * HALF + 4 * n); }
        float rs[2][4]; if (FUSED) normfix_rstd(nf, lds, par, wr * 64 + fr, rs);
#pragma unroll
        for (int ai = 0; ai < 2; ++ai)
#pragma unroll
            for (int m = 0; m < 4; ++m) { const int row = row0 + ai * HALF + m * 16, tpos = row % SEQ_ROWS; bf16_t* rowp = base + (size_t)row * ldc + col0;
                f32x4 s0 = {0.f, 0.f, 0.f, 0.f}, s1 = s0, c0 = {1.f, 1.f, 1.f, 1.f}, c1 = c0;
                if (dorope && fq < 2) { s0 = *(const __attribute__((address_space(1))) f32x4*)(sint + tpos * 8); s1 = *(const __attribute__((address_space(1))) f32x4*)(sint + tpos * 8 + 4); c0 = *(const __attribute__((address_space(1))) f32x4*)(cost + tpos * 8); c1 = *(const __attribute__((address_space(1))) f32x4*)(cost + tpos * 8 + 4); }
#pragma unroll
                for (int bj = 0; bj < 2; ++bj) { f32x4 v0 = acc[ai][bj][m][0], v1 = acc[ai][bj][m][1];
                    if (FUSED) { v0 = v0 * rs[ai][m]; v1 = v1 * rs[ai][m]; }
                    v0 += bv[bj][0]; v1 += bv[bj][1];
                    if (dorope) { f32x4 p0, p1;
#pragma unroll
                        for (int j = 0; j < 4; ++j) { p0[j] = __shfl_xor(v0[j], 16); p1[j] = __shfl_xor(v1[j], 16); }
                        v0 = v0 * c0 + (p0 * s0) * sgn; v1 = v1 * c1 + (p1 * s1) * sgn; }
                    v0 = v0 * scale; v1 = v1 * scale;
                    u32x4 w; w.x = cvt_pk_bf16(v0[0], v0[1]); w.y = cvt_pk_bf16(v0[2], v0[3]); w.z = cvt_pk_bf16(v1[0], v1[1]); w.w = cvt_pk_bf16(v1[2], v1[3]);
                    *(__attribute__((address_space(1))) u32x4*)(rowp + bj * HALF) = w; } }
    }
};

template <class Epi, class Sched, bool ALIGN_EPI = false, bool SP2 = false>
__device__ __forceinline__ void gemm_phase(PG8_LAS unsigned char* lds, const Gemm g, const Sched& S, const Epi& E) {
    const int tid = threadIdx.x, wid = __builtin_amdgcn_readfirstlane(tid >> 6), lane = tid & 63, wr = wid >> 2, wc = wid & 3, fr = lane & 15, fq = lane >> 4;
    const int K = g.K, nt = K / BK;
    unsigned voffA[2], voffB[2];
#pragma unroll
    for (int i = 0; i < 2; ++i) { int R, C; stage_rc(tid * 16 + i * 8192, R, C); const int Rb = Epi::PERM ? ((R & ~31) + perm32(R & 31)) : R;
        voffA[i] = (unsigned)(R * g.rsA + C * 2); voffB[i] = (unsigned)(Rb * g.rsB + C * 2); }
    const size_t kstepA = (size_t)g.ksA, kstepB = (size_t)g.ksB;
    const size_t hstepA = (size_t)HALF * g.rsA, hstepB = (size_t)HALF * g.rsB;
    const size_t tstepA = 2 * hstepA, tstepB = 2 * hstepB;
    const unsigned ldsw = (unsigned)wid * 1024u; const unsigned ldsbase = (unsigned)__builtin_amdgcn_readfirstlane((int)((unsigned)(size_t)lds + ldsw));
    const int aoff = lds_byte(wr * 64 + fr, fq * 8), boff = lds_byte(wc * 32 + fr, fq * 8);
#define PG8_SA(b, h) (((b) * 2 + (h)) * HTB)
#define PG8_SB(b, h) ((4 + (b) * 2 + (h)) * HTB)
#define PG8_DMA1(gbase_, voff32_, ldsdst_) do { unsigned _keep; asm volatile("s_mov_b32 %0, m0\n\ts_mov_b32 m0, %3\n\ts_nop 0\n\tglobal_load_lds_dwordx4 %1, %2\n\ts_mov_b32 m0, %0" \
        : "=&s"(_keep) : "v"(voff32_), "s"((unsigned long long)(gbase_)), "s"(ldsdst_) : "memory"); } while (0)
#define PG8_STAGE(bufoff, gbase, voff) do { _Pragma("unroll") for (int _i = 0; _i < 2; ++_i) PG8_DMA1((const char*)(gbase), (voff)[_i], ldsbase + (unsigned)((bufoff) + _i * 8192)); } while (0)
#define PG8_LDA(dst, b, h) do { _Pragma("unroll") for (int m = 0; m < 4; ++m) _Pragma("unroll") for (int k = 0; k < 2; ++k) dst[m][k] = *(const PG8_LAS bf16x8*)(lds + PG8_SA(b, h) + aoff + m * 2048 + k * 1024); } while (0)
#define PG8_LDB(dst, b, h) do { _Pragma("unroll") for (int n = 0; n < 2; ++n) _Pragma("unroll") for (int k = 0; k < 2; ++k) dst[n][k] = *(const PG8_LAS bf16x8*)(lds + PG8_SB(b, h) + boff + n * 2048 + k * 1024); } while (0)
#define PG8_MMA(ai, bj, At, Bt) do { __builtin_amdgcn_s_setprio(1); _Pragma("unroll") for (int m = 0; m < 4; ++m) _Pragma("unroll") for (int n = 0; n < 2; ++n) _Pragma("unroll") for (int k = 0; k < 2; ++k) \
        acc[ai][bj][m][n] = __builtin_amdgcn_mfma_f32_16x16x32_bf16(Bt[n][k], At[m][k], acc[ai][bj][m][n], 0, 0, 0); __builtin_amdgcn_s_setprio(0); } while (0)
#define PG8_WAIT_V(n) asm volatile("s_waitcnt vmcnt(" #n ")" ::: "memory")
#define PG8_WAIT_L(n) asm volatile("s_waitcnt lgkmcnt(" #n ")" ::: "memory")
#define PG8_BAR __builtin_amdgcn_s_barrier()
#define PG8_SCHED __builtin_amdgcn_sched_barrier(0)
    Unit cur, nxt; int ui = 0;
    if (!S.next(0, cur)) return;
    f32x4 acc[2][2][4][2];
#pragma unroll
    for (int a = 0; a < 2; ++a)
#pragma unroll
        for (int b = 0; b < 2; ++b)
#pragma unroll
            for (int m = 0; m < 4; ++m)
#pragma unroll
                for (int n = 0; n < 2; ++n) acc[a][b][m][n] = (f32x4){0.f, 0.f, 0.f, 0.f};
    bf16x8 At[4][2], B0[2][2], B1[2][2];
    const char* cA = (const char*)g.A + (size_t)(cur.pm & g.opmask) * tstepA; const char* cB = (const char*)g.Bt + (size_t)(cur.pn & g.opmask) * tstepB;
    S.a_ready(cur);
    E.prefetch(lds, cur, 0, wid, lane);
    if constexpr (SP2) {
        PG8_STAGE(PG8_SB(0, 0), cB, voffB); PG8_STAGE(PG8_SB(0, 1), cB + hstepB, voffB); PG8_STAGE(PG8_SA(0, 0), cA, voffA); PG8_STAGE(PG8_SA(0, 1), cA + hstepA, voffA);
        PG8_STAGE(PG8_SB(1, 0), cB + kstepB, voffB); PG8_STAGE(PG8_SB(1, 1), cB + hstepB + kstepB, voffB);
        if (wr == 1) PG8_BAR;
        PG8_WAIT_V(4); PG8_BAR; PG8_BAR;
    } else {
        PG8_STAGE(PG8_SB(0, 0), cB, voffB); PG8_STAGE(PG8_SA(0, 0), cA, voffA); PG8_STAGE(PG8_SB(0, 1), cB + hstepB, voffB); PG8_STAGE(PG8_SA(0, 1), cA + hstepA, voffA);
        if (wr == 1) PG8_BAR;
        PG8_WAIT_V(4); PG8_BAR;
        PG8_STAGE(PG8_SB(1, 0), cB + kstepB, voffB); PG8_STAGE(PG8_SA(1, 0), cA + kstepA, voffA); PG8_STAGE(PG8_SB(1, 1), cB + hstepB + kstepB, voffB);
        PG8_WAIT_V(6); PG8_BAR;
    }
    for (;;) {
        const bool has_next = S.next(ui + 1, nxt);
        const char* nA = has_next ? (const char*)g.A + (size_t)(nxt.pm & g.opmask) * tstepA : cA; const char* nB = has_next ? (const char*)g.Bt + (size_t)(nxt.pn & g.opmask) * tstepB : cB;
        for (int t = 0; t < nt; t += 2) {
            const bool last = (t == nt - 2);
            const char* a1 = cA + (size_t)(t + 1) * kstepA;
            const char* a2 = last ? nA : cA + (size_t)(t + 2) * kstepA; const char* b2 = last ? nB : cB + (size_t)(t + 2) * kstepB;
            const char* a3 = a2 + kstepA; const char* b3 = b2 + kstepB;
            if (last && has_next) { S.a_ready(nxt); E.prefetch(lds, nxt, (ui + 1) & 1, wid, lane); }
            if constexpr (SP2) {
            PG8_LDB(B0, 0, 0); PG8_LDB(B1, 0, 1); PG8_SCHED; PG8_LDA(At, 0, 0); PG8_STAGE(PG8_SA(1, 0), a1, voffA); PG8_STAGE(PG8_SA(1, 1), a1 + hstepA, voffA);
            PG8_WAIT_V(8); PG8_WAIT_L(0); PG8_BAR; PG8_MMA(0, 0, At, B0); PG8_MMA(0, 1, At, B1); PG8_BAR; PG8_SCHED;
            PG8_LDA(At, 0, 1); PG8_STAGE(PG8_SB(0, 0), b2, voffB); PG8_STAGE(PG8_SB(0, 1), b2 + hstepB, voffB);
            PG8_WAIT_V(4); PG8_WAIT_L(0); PG8_BAR; PG8_MMA(1, 0, At, B0); PG8_MMA(1, 1, At, B1); PG8_BAR; PG8_SCHED;
            PG8_LDB(B0, 1, 0); PG8_LDB(B1, 1, 1); PG8_SCHED; PG8_LDA(At, 1, 0); PG8_STAGE(PG8_SA(0, 0), a2, voffA); PG8_STAGE(PG8_SA(0, 1), a2 + hstepA, voffA);
            PG8_WAIT_V(8); PG8_WAIT_L(0); PG8_BAR; PG8_MMA(0, 0, At, B0); PG8_MMA(0, 1, At, B1); PG8_BAR; PG8_SCHED;
            PG8_LDA(At, 1, 1); PG8_STAGE(PG8_SB(1, 0), b3, voffB); PG8_STAGE(PG8_SB(1, 1), b3 + hstepB, voffB);
            PG8_WAIT_V(4); PG8_WAIT_L(0); PG8_BAR; PG8_MMA(1, 0, At, B0); PG8_MMA(1, 1, At, B1); PG8_BAR; PG8_SCHED;
            } else {
            PG8_LDB(B0, 0, 0); PG8_SCHED; PG8_LDA(At, 0, 0); PG8_STAGE(PG8_SA(1, 1), a1 + hstepA, voffA);
            PG8_WAIT_L(8); PG8_BAR; PG8_WAIT_L(0); PG8_MMA(0, 0, At, B0); PG8_BAR; PG8_SCHED;
            PG8_LDB(B1, 0, 1); PG8_STAGE(PG8_SB(0, 0), b2, voffB);
            PG8_BAR; PG8_WAIT_L(0); PG8_MMA(0, 1, At, B1); PG8_BAR;
            PG8_LDA(At, 0, 1); PG8_STAGE(PG8_SA(0, 0), a2, voffA);
            PG8_BAR; PG8_WAIT_L(0); PG8_MMA(1, 0, At, B0); PG8_BAR; PG8_SCHED;
            PG8_STAGE(PG8_SB(0, 1), b2 + hstepB, voffB);
            PG8_WAIT_V(6); PG8_BAR; PG8_MMA(1, 1, At, B1); PG8_BAR;
            PG8_LDB(B0, 1, 0); PG8_SCHED; PG8_LDA(At, 1, 0); PG8_STAGE(PG8_SA(0, 1), a2 + hstepA, voffA);
            PG8_WAIT_L(8); PG8_BAR; PG8_WAIT_L(0); PG8_MMA(0, 0, At, B0); PG8_BAR; PG8_SCHED;
            PG8_LDB(B1, 1, 1); PG8_STAGE(PG8_SB(1, 0), b3, voffB);
            PG8_BAR; PG8_WAIT_L(0); PG8_MMA(0, 1, At, B1); PG8_BAR;
            PG8_LDA(At, 1, 1); PG8_STAGE(PG8_SA(1, 0), a3, voffA);
            PG8_BAR; PG8_WAIT_L(0); PG8_MMA(1, 0, At, B0); PG8_BAR; PG8_SCHED;
            PG8_STAGE(PG8_SB(1, 1), b3 + hstepB, voffB);
            PG8_WAIT_V(6); PG8_BAR; PG8_MMA(1, 1, At, B1); PG8_BAR;
            }
        }
        if constexpr (ALIGN_EPI) { if (wr == 0) PG8_BAR; }
        if constexpr (!Epi::AFTER_DRAIN) { E(acc, cur, wr, wc, fr, fq, lds, ui & 1); S.done(cur); }
        if (!has_next) break;
#pragma unroll
        for (int a = 0; a < 2; ++a)
#pragma unroll
            for (int b = 0; b < 2; ++b)
#pragma unroll
                for (int m = 0; m < 4; ++m)
#pragma unroll
                    for (int n = 0; n < 2; ++n) acc[a][b][m][n] = (f32x4){0.f, 0.f, 0.f, 0.f};
        cur = nxt; cA = nA; cB = nB; ++ui;
        if constexpr (ALIGN_EPI) { if (wr == 1) PG8_BAR; }
    }
    PG8_WAIT_V(0);
    if constexpr (!ALIGN_EPI) { if (wr == 0) PG8_BAR; }
    PG8_BAR;
    if constexpr (Epi::AFTER_DRAIN) { E.fused(acc, cur, wr, wc, fr, fq, lds, wid, lane); S.done(cur); }
#undef PG8_SA
#undef PG8_SB
#undef PG8_STAGE
#undef PG8_LDA
#undef PG8_LDB
#undef PG8_MMA
#undef PG8_WAIT_V
#undef PG8_WAIT_L
#undef PG8_BAR
#undef PG8_SCHED
}
}

constexpr int BATCH = 4, SEQ = 4096, M = BATCH * SEQ, D = 2048, DFF = 5504, NFF = 2 * DFF;
constexpr int HH = 16, HK = 128;
constexpr int NQ = 32, NKV = 4, HD = 64, WIN = 128, KVD = NKV * HD;
constexpr float EPS = 1e-6f;
constexpr float QSCALE = 0.125f * 1.4426950408889634f;
constexpr int NWAVES = 8;
static_assert(SEQ == pg8::SEQ_ROWS, "SEQ");

constexpr size_t MiB = 1u << 20;
constexpr size_t WS_CTL = 0, CTL_ZERO_BYTES = 64 * 1024;
constexpr size_t WS_MOD0 = 1 * MiB, WS_MOD1 = WS_MOD0 + (size_t)BATCH * 9 * D * 4, WS_KVMOD = WS_MOD1 + (size_t)BATCH * 9 * D * 4, WS_LB = WS_KVMOD + (size_t)BATCH * 2 * D * 4,
                 WS_SIN = WS_LB + (size_t)D * 4, WS_COS = WS_SIN + (size_t)SEQ * 8 * 4, WS_SMALL_END = WS_COS + (size_t)SEQ * 8 * 4;
static_assert(WS_SMALL_END <= 2 * MiB, "small region");
constexpr size_t SZ_WFI = (size_t)NFF * D * 2, SZ_WFO = (size_t)D * DFF * 2;
constexpr size_t WS_WFI = 2 * MiB, WS_WFO = WS_WFI + 4 * SZ_WFI, WS_WHI = WS_WFO + 4 * SZ_WFO, WS_WHO = WS_WHI + (size_t)4 * D * D * 2, WS_WKV = WS_WHO + (size_t)D * D * 2,
                 WS_WQ = WS_WKV + 2 * MiB, WS_WAO = WS_WQ + (size_t)D * D * 2, WS_U = WS_WAO + (size_t)D * D * 2, WS_UKV = WS_U + (size_t)M * D * 2, WS_HID = WS_UKV + (size_t)M * D * 2,
                 WS_QKVG = WS_HID + (size_t)M * DFF * 2, WS_OG = WS_QKVG + (size_t)M * 4 * D * 2, WS_Q = WS_OG + (size_t)M * D * 2, WS_K = WS_Q + (size_t)M * D * 2, WS_V = WS_K + (size_t)M * KVD * 2,
                 WS_HS = WS_V + (size_t)M * KVD * 2, WS_HD = WS_HS + (size_t)BATCH * HH * 8 * HK * HK * 4, WS_SW = WS_HD + 1 * MiB, WS_Y = WS_SW + 1 * MiB, WS_H16 = WS_Y + (size_t)M * D * 2, WS_END = WS_H16 + (size_t)M * D * 2;
static_assert(WS_WFI % MiB == 0 && WS_WFO % MiB == 0 && WS_WHI % MiB == 0 && WS_U % MiB == 0 && WS_HID % MiB == 0 && WS_QKVG % MiB == 0 && WS_HS % MiB == 0, "ws alignment");
constexpr int CW_TMO = 0, CW_CODE = 1, CW_BAR = 4096;
constexpr int CW_ROWSS = 32768, N_ROWSS = 5;
static_assert((size_t)(CW_BAR + 3 * 3456) * 4 <= CTL_ZERO_BYTES, "barrier words inside the memset region");
constexpr int SWO_HI = 0, SWO_F1 = SWO_HI + 4 * 4 * D, SWO_KV = SWO_F1 + 4 * NFF, SWO_F2 = SWO_KV + 4 * 2 * KVD, SWO_Q = SWO_F2 + 4 * NFF, SWO_F3 = SWO_Q + 4 * D, SWO_END = SWO_F3 + 4 * NFF;
static_assert((size_t)SWO_END * 4 <= MiB, "sw region");

constexpr int RING_OFF = 0, RING_BYTES = 147456, LDSCTL_OFF = RING_BYTES, MISC_OFF = LDSCTL_OFF + 320, LDS_BYTES = 149504;

#define GAS __attribute__((address_space(1)))
#define LAS __attribute__((address_space(3)))
typedef unsigned short bf16;
typedef unsigned v4u __attribute__((ext_vector_type(4)));
typedef unsigned v2u __attribute__((ext_vector_type(2)));
typedef float f32x4 __attribute__((ext_vector_type(4)));
typedef GAS unsigned gu32;
#define RLX_AGENT __ATOMIC_RELAXED, __HIP_MEMORY_SCOPE_AGENT
#define LDS_WAIT() asm volatile("s_waitcnt lgkmcnt(0)" ::: "memory")
#define VM_WAIT() asm volatile("s_waitcnt vmcnt(0)" ::: "memory")
__device__ __forceinline__ unsigned f2bf(float f) { unsigned u = __builtin_bit_cast(unsigned, f); return (u + 0x7fffu + ((u >> 16) & 1u)) >> 16; }
__device__ __forceinline__ unsigned pk2(float lo, float hi) { return f2bf(lo) | (f2bf(hi) << 16); }
__device__ __forceinline__ float bf2f(unsigned short b) { return __builtin_bit_cast(float, ((unsigned)b) << 16); }
__device__ __forceinline__ float h2f(unsigned short b) { return (float)__builtin_bit_cast(_Float16, b); }
typedef _Float16 f16x2_t __attribute__((ext_vector_type(2)));
__device__ __forceinline__ unsigned pkh(float lo, float hi) { f16x2_t v = {(_Float16)lo, (_Float16)hi}; return __builtin_bit_cast(unsigned, v); }
#define XB_TMO      128
#define XB_XCNT(j)  (256  + 64 * (j))
#define XB_XSUB(j)  (1280 + 64 * (j))
#define XB_XGEN(j)  (2304 + 64 * (j))
#define XB_TOP      3328
#define XB_TOPGEN   3392
#define XCD_BAR_WORDS 3456
#define XB_SPIN_CAP (1u << 18)

__device__ __forceinline__ unsigned xb_ld(unsigned* p)              { return __hip_atomic_load(p, __ATOMIC_RELAXED, __HIP_MEMORY_SCOPE_AGENT); }
__device__ __forceinline__ unsigned xb_add(unsigned* p, unsigned v) { return __hip_atomic_fetch_add(p, v, __ATOMIC_RELAXED, __HIP_MEMORY_SCOPE_AGENT); }
__device__ __forceinline__ unsigned xb_xcc_id() { return (unsigned)__builtin_amdgcn_s_getreg((3 << 11) | 20) & 0xFu; }
#define XB_SPIN(cond, bar) do { unsigned _sp = 0; while (cond) { __builtin_amdgcn_s_sleep(1); \
    if ((++_sp & 255u) == 0u) { if (xb_ld(&(bar)[XB_TMO])) break; if (_sp > XB_SPIN_CAP) { atomicAdd(&(bar)[XB_TMO], 1u); break; } } } } while (0)

struct XcdBarrier {
    unsigned* bar; unsigned x;
    volatile LAS unsigned* st;
};

__device__ __forceinline__ XcdBarrier xcd_barrier_post(unsigned* bar, volatile LAS unsigned* st) {
    XcdBarrier b; b.bar = bar; b.x = xb_xcc_id(); b.st = st;
    if (threadIdx.x == 0) (void)xb_add(&bar[XB_XCNT(b.x)], 1u);
    return b;
}
__device__ __forceinline__ void xcd_barrier_complete(unsigned* bar, unsigned x, unsigned& nloc, unsigned& nx) {
    const unsigned G = gridDim.x * gridDim.y * gridDim.z;
    unsigned sum, cnt, mine, sp = 0u;
    for (;;) {
        sum = 0u; cnt = 0u; mine = 0u;
#pragma unroll
        for (unsigned j = 0; j < 16; ++j) { const unsigned c = xb_ld(&bar[XB_XCNT(j)]); sum += c; cnt += (c > 0u) ? 1u : 0u; mine = (j == x) ? c : mine; }
        if (sum == G) break;
        __builtin_amdgcn_s_sleep(1);
        if ((++sp & 255u) == 0u) { if (xb_ld(&bar[XB_TMO])) break; if (sp > XB_SPIN_CAP) { atomicAdd(&bar[XB_TMO], 1u); break; } }
    }
    nloc = mine > 0u ? mine : 1u; nx = cnt > 0u ? cnt : 1u;
}

__device__ __forceinline__ void xcd_barrier_leader(const XcdBarrier& b) {
    unsigned* bar = b.bar;
    __builtin_amdgcn_s_waitcnt(0);
    unsigned nloc = b.st[0], nx = b.st[1];
    if (nloc == 0u) { xcd_barrier_complete(bar, b.x, nloc, nx); b.st[0] = nloc; b.st[1] = nx; }
    const unsigned old = xb_add(&bar[XB_XSUB(b.x)], 1u);
    const unsigned gen = old / nloc;
    if (old + 1u == (gen + 1u) * nloc) {
        __builtin_amdgcn_fence(__ATOMIC_RELEASE, "agent");
        asm volatile("s_waitcnt vmcnt(0)" ::: "memory");
        const unsigned og = xb_add(&bar[XB_TOP], 1u);
        const unsigned tg = og / nx;
        if (og + 1u == (tg + 1u) * nx) xb_add(&bar[XB_TOPGEN], 1u);
        else XB_SPIN(xb_ld(&bar[XB_TOPGEN]) == tg, bar);
        __builtin_amdgcn_fence(__ATOMIC_ACQUIRE, "agent");
        xb_add(&bar[XB_XGEN(b.x)], 1u);
        asm volatile("s_waitcnt vmcnt(0)" ::: "memory");
    } else {
        XB_SPIN(xb_ld(&bar[XB_XGEN(b.x)]) == gen, bar);
        __builtin_amdgcn_fence(__ATOMIC_ACQUIRE, "agent");
        asm volatile("s_waitcnt vmcnt(0)" ::: "memory");
    }
}
__device__ __forceinline__ void xcd_barrier(const XcdBarrier& b) {
    asm volatile("s_waitcnt vmcnt(0)" ::: "memory");
    __syncthreads();
    if (threadIdx.x == 0) xcd_barrier_leader(b);
    __syncthreads();
}

#define XB_MISMATCH 3400
#define XB_GRP(g)   (XCD_BAR_WORDS + 32 * (g))
constexpr unsigned GRP_N = 4u;
#define XB_SIG(i)   (XCD_BAR_WORDS + 32 * 64 + 64 * (i))
__device__ __forceinline__ void xb_signal(const XcdBarrier& b, int i) {
    asm volatile("s_waitcnt vmcnt(0)" ::: "memory");
    __syncthreads();
    if (threadIdx.x == 0) { __builtin_amdgcn_fence(__ATOMIC_RELEASE, "agent"); asm volatile("s_waitcnt vmcnt(0)" ::: "memory"); (void)xb_add(&b.bar[XB_SIG(i)], 1u); }
}
__device__ __forceinline__ void xb_wait(const XcdBarrier& b, int i, unsigned n) {
    if (threadIdx.x == 0) { XB_SPIN(xb_ld(&b.bar[XB_SIG(i)]) < n, b.bar); __builtin_amdgcn_fence(__ATOMIC_ACQUIRE, "agent"); asm volatile("s_waitcnt vmcnt(0)" ::: "memory"); }
    __syncthreads();
}
__device__ __forceinline__ void grp_barrier(const XcdBarrier& b, int sig = -1, unsigned sig_n = 0u) {
    asm volatile("s_waitcnt vmcnt(0)" ::: "memory");
    __syncthreads();
    if (threadIdx.x == 0) {
        if (b.st[2] != 0u) {
            unsigned* cnt = &b.bar[XB_GRP(b.st[3] - 1u)];
            __builtin_amdgcn_s_waitcnt(0);
            const unsigned old = xb_add(cnt, 1u);
            const unsigned target = (old / GRP_N + 1u) * GRP_N;
            XB_SPIN(xb_ld(cnt) < target, b.bar);
            if (sig >= 0) XB_SPIN(xb_ld(&b.bar[XB_SIG(sig)]) < sig_n, b.bar);
            __builtin_amdgcn_fence(__ATOMIC_ACQUIRE, "agent");
            asm volatile("s_waitcnt vmcnt(0)" ::: "memory");
        } else xcd_barrier_leader(b);
    }
    __syncthreads();
}

struct Frame {
    LAS unsigned char* lds;
    volatile LAS unsigned* MISC;
    gu32* ctl;
    int tid, lane, wave, G;
    const float *x, *c, *norm_gain, *w_ada, *b_ada, *w_ffn_in, *w_ffn_out, *w_hgrn_in, *lb_logits, *hgain, *w_hgrn_out, *kv_gain, *w_ada_kv, *b_ada_kv, *w_kv, *b_kv, *w_q, *b_q, *sinks, *w_ao, *final_gain;
    float* out; unsigned char* ws;
};
__device__ __forceinline__ float wave_sum(float v) {
#pragma unroll
    for (int o = 1; o < 64; o <<= 1) v += __shfl_xor(v, o);
    return v;
}
__device__ __forceinline__ int frame_pm(const Frame& F) { return __builtin_amdgcn_readfirstlane((int)F.MISC[11]) - 1; }
__device__ __forceinline__ int frame_q(const Frame& F) { return __builtin_amdgcn_readfirstlane((int)F.MISC[12]); }
struct RowMap { int row0, stride, end; };
__device__ __forceinline__ RowMap norm_rows(const Frame& F) {
    RowMap r; const int pm = frame_pm(F), q = frame_q(F);
    if (pm >= 0) { r.row0 = pm * 256 + q * NWAVES + F.wave; r.stride = 4 * NWAVES; r.end = pm * 256 + 256; }
    else { r.row0 = blockIdx.x * NWAVES + F.wave; r.stride = F.G * NWAVES; r.end = M; }
    return r;
}
struct TItem { const float* W; bf16* WT; int K, N, item; bool ilv, blocked; };
__device__ __forceinline__ void p0_item_load(const TItem& T, float (&v)[32], int lane) {
    const int nblk = T.N / 32, kb = T.item / nblk, nb = T.item % nblk, k0 = 64 * kb, n0 = 32 * nb;
    const float* wp = T.W + (size_t)(k0 + (lane >> 5)) * T.N + n0 + (lane & 31);
#pragma unroll
    for (int i = 0; i < 32; ++i) v[i] = __builtin_nontemporal_load(wp + (size_t)(2 * i) * T.N);
}
__device__ __forceinline__ void p0_item_store(const TItem& T, const float (&v)[32], LAS float* scr, int lane) {
    const int nblk = T.N / 32, kb = T.item / nblk, nb = T.item % nblk, k0 = 64 * kb, n0 = 32 * nb;
    int drow0 = n0;
    if (T.ilv) { const int half = n0 >= DFF ? 1 : 0, j = n0 - half * DFF; drow0 = 256 * (j >> 7) + 128 * half + (j & 127); }
    const float wsc = T.ilv ? (n0 >= DFF ? -0.6931471805599453f : -1.4426950408889634f) : 1.0f;
#pragma unroll
    for (int i = 0; i < 32; ++i) scr[(2 * i + (lane >> 5)) * 33 + (lane & 31)] = v[i] * wsc;
    LDS_WAIT(); asm volatile("" ::: "memory");
    const int c = lane & 7;
#pragma unroll
    for (int j = 0; j < 4; ++j) { const int n = (lane >> 3) + 8 * j; const LAS float* s = scr + (8 * c) * 33 + n;
        v4u o; o.x = pk2(s[0 * 33], s[1 * 33]); o.y = pk2(s[2 * 33], s[3 * 33]); o.z = pk2(s[4 * 33], s[5 * 33]); o.w = pk2(s[6 * 33], s[7 * 33]);
        const size_t doff = T.blocked ? ((size_t)kb * T.N + drow0 + n) * 64 + 8 * c : (size_t)(drow0 + n) * T.K + k0 + 8 * c;
        *(GAS v4u*)(T.WT + doff) = o; }
    LDS_WAIT(); asm volatile("" ::: "memory");
}
constexpr int I_FI = (D / 64) * (NFF / 32), I_FO = (DFF / 64) * (D / 32), I_HI = (D / 64) * (4 * D / 32), I_DD = (D / 64) * (D / 32), I_KV = (D / 64) * (2 * KVD / 32);
constexpr int NITEMS = 4 * I_FI + 4 * I_FO + I_HI + 3 * I_DD + I_KV;
constexpr int DEF1_LO = 2 * I_FI, DEF1_HI = 4 * I_FI, DEF2_LO = 4 * I_FI + 1 * I_FO, DEF2_HI = 4 * I_FI + 4 * I_FO, DEF3_LO = 4 * I_FI + 4 * I_FO + I_HI + I_DD, DEF3_HI = DEF3_LO + 2 * I_DD;
constexpr int NDEF = (DEF1_HI - DEF1_LO) + (DEF2_HI - DEF2_LO) + (DEF3_HI - DEF3_LO), NITEMS_P0 = NITEMS - NDEF;
constexpr int DC1 = I_FO, DC2 = DC1 + I_FI, DC3 = DC2 + 2 * I_DD, DC4 = DC3 + I_FO, DC5 = DC4 + I_FI, DC6 = DC5 + I_FO;
static_assert(DC6 == NDEF, "deferred list");
constexpr int SLOT_A_LO = 0, SLOT_A_HI = 7000, SLOT_B_HI = 14000, SLOT_C_HI = DC3, SLOT_D_HI = DC4, SLOT_KV_LO = DC4, SLOT_KV_HI = DC6;
static_assert(SLOT_A_HI >= DC1 && SLOT_B_HI <= DC2 && SLOT_C_HI > SLOT_B_HI, "slot bounds: FFN-out[1] inside the first slot (needed by the second FFN), FFN-in[3] before W_q");
__device__ __forceinline__ int tr_p0_index(int d) {
    if (d >= DEF1_LO) d += DEF1_HI - DEF1_LO;
    if (d >= DEF2_LO) d += DEF2_HI - DEF2_LO;
    if (d >= DEF3_LO) d += DEF3_HI - DEF3_LO;
    return d;
}
__device__ __forceinline__ int tr_def_index(int e) {
    if (e < DC1) return 4 * I_FI + 1 * I_FO + e;
    if (e < DC2) return 3 * I_FI + (e - DC1);
    if (e < DC3) return DEF3_LO + (e - DC2);
    if (e < DC4) return 4 * I_FI + 3 * I_FO + (e - DC3);
    if (e < DC5) return 2 * I_FI + (e - DC4);
    return 4 * I_FI + 2 * I_FO + (e - DC5);
}
__device__ __forceinline__ void tr_decode(Frame& F, int it, TItem& T) {
    T.ilv = false; T.blocked = false; T.K = D; T.N = D; T.item = -1; T.W = nullptr; T.WT = nullptr;
    if (it < 0 || it >= NITEMS) return;
    if (it < 4 * I_FI) { const int f = it / I_FI; T.W = F.w_ffn_in + (size_t)f * D * NFF; T.WT = (bf16*)(F.ws + WS_WFI + f * SZ_WFI); T.K = D; T.N = NFF; T.ilv = true; T.item = it % I_FI; return; } it -= 4 * I_FI;
    if (it < 4 * I_FO) { const int f = it / I_FO; T.W = F.w_ffn_out + (size_t)f * DFF * D; T.WT = (bf16*)(F.ws + WS_WFO + f * SZ_WFO); T.K = DFF; T.N = D; T.blocked = true; T.item = it % I_FO; return; } it -= 4 * I_FO;
    if (it < I_HI) { T.W = F.w_hgrn_in; T.WT = (bf16*)(F.ws + WS_WHI); T.N = 4 * D; T.item = it; return; } it -= I_HI;
    if (it < I_DD) { T.W = F.w_hgrn_out; T.WT = (bf16*)(F.ws + WS_WHO); T.item = it; return; } it -= I_DD;
    if (it < I_DD) { T.W = F.w_q; T.WT = (bf16*)(F.ws + WS_WQ); T.item = it; return; } it -= I_DD;
    if (it < I_DD) { T.W = F.w_ao; T.WT = (bf16*)(F.ws + WS_WAO); T.item = it; return; } it -= I_DD;
    T.W = F.w_kv; T.WT = (bf16*)(F.ws + WS_WKV); T.N = 2 * KVD; T.item = it;
}
__device__ __forceinline__ void tr_deferred(Frame& F, int lo, int hi, int first_wg, int n_wg) {
    LAS float* scr = (LAS float*)(F.lds + F.wave * 8448);
    const int w = ((int)blockIdx.x - first_wg) * NWAVES + F.wave, NW = n_wg * NWAVES;
    TItem Tc, Tn; float vc[32], vn[32];
    int e = lo + w; bool have = e < hi;
    if (have) { tr_decode(F, tr_def_index(e), Tc); p0_item_load(Tc, vc, F.lane); }
    while (have) {
        const int en = e + NW; const bool hn = en < hi;
        if (hn) { tr_decode(F, tr_def_index(en), Tn); p0_item_load(Tn, vn, F.lane); }
        p0_item_store(Tc, vc, scr, F.lane);
        Tc = Tn; have = hn; e = en;
#pragma unroll
        for (int i = 0; i < 32; ++i) vc[i] = vn[i];
    }
}
__device__ __forceinline__ void p0_gemv_task(Frame& F, const float* W, const float* bias, float* outp, int N, int n0) {
    LAS float* cs = (LAS float*)(F.lds);
    LAS float* red = (LAS float*)(F.lds + 32768);
    f32x4 a0 = {0.f, 0.f, 0.f, 0.f}, a1 = a0, a2 = a0, a3 = a0;
    const float* wp = W + (size_t)(F.wave * 256) * N + n0 + 4 * F.lane;
#pragma unroll 16
    for (int k = 0; k < 256; ++k) { const f32x4 w = __builtin_nontemporal_load((const f32x4*)(wp + (size_t)k * N)); const int kk = F.wave * 256 + k;
        a0 += w * cs[kk]; a1 += w * cs[2048 + kk]; a2 += w * cs[4096 + kk]; a3 += w * cs[6144 + kk]; }
    LAS float* r = red + F.wave * 1024 + 4 * F.lane;
    *(LAS f32x4*)(r) = a0; *(LAS f32x4*)(r + 256) = a1; *(LAS f32x4*)(r + 512) = a2; *(LAS f32x4*)(r + 768) = a3;
    __syncthreads();
    for (int o = F.tid; o < 1024; o += NWAVES * 64) { float s = 0.f;
#pragma unroll
        for (int w = 0; w < 8; ++w) s += red[w * 1024 + o];
        const int b = o >> 8, n = n0 + (o & 255); outp[(size_t)b * N + n] = s + bias[n]; }
    __syncthreads();
}
__device__ __forceinline__ void p0_prologue(Frame& F, const XcdBarrier& bar, int sig_mod) {
    float* mod0 = (float*)(F.ws + WS_MOD0); float* mod1 = (float*)(F.ws + WS_MOD1); float* kvmod = (float*)(F.ws + WS_KVMOD);
    const int bx = blockIdx.x;
    for (int i = bx * 512 + F.tid; i < SEQ * 8; i += F.G * 512) { const int t = i >> 3, j = i & 7; const float inv = powf(500000.0f, -(float)(2 * j) / 16.0f); const float ang = (float)t * inv;
        ((float*)(F.ws + WS_SIN))[i] = (float)sin((double)ang); ((float*)(F.ws + WS_COS))[i] = (float)cos((double)ang); }
    for (int i = bx * 512 + F.tid; i < D; i += F.G * 512) { const float a = F.lb_logits[i], b = F.lb_logits[D + i], m = fmaxf(a, b), ea = expf(a - m), eb = expf(b - m); ((float*)(F.ws + WS_LB))[i] = ea / (ea + eb); }
    constexpr int NT0 = 9 * D / 256, NTK = 2 * D / 256, NGEMV = 2 * NT0 + NTK;
    if (bx < NGEMV) {
        LAS float* cs = (LAS float*)(F.lds);
        for (int i = F.tid; i < BATCH * D; i += NWAVES * 64) { const float v = F.c[i]; cs[i] = v / (1.f + expf(-v)); }
        __syncthreads();
        for (int task = bx; task < NGEMV; task += F.G) {
            if (task < NT0) p0_gemv_task(F, F.w_ada, F.b_ada, mod0, 9 * D, task * 256);
            else if (task < 2 * NT0) p0_gemv_task(F, F.w_ada + (size_t)D * 9 * D, F.b_ada + 9 * D, mod1, 9 * D, (task - NT0) * 256);
            else p0_gemv_task(F, F.w_ada_kv, F.b_ada_kv, kvmod, 2 * D, (task - 2 * NT0) * 256);
        }
    }
    xb_signal(bar, sig_mod);
    LAS float* scr = (LAS float*)(F.lds + F.wave * 8448);
    int pbase, pw, ptot;
    constexpr int SH_G = 6, SH_O = 13;
    if (F.G > NGEMV) { ptot = NGEMV * SH_G + (F.G - NGEMV) * SH_O; if (bx < NGEMV) { pbase = bx * SH_G; pw = SH_G; } else { pbase = NGEMV * SH_G + (bx - NGEMV) * SH_O; pw = SH_O; } }
    else { ptot = F.G; pbase = bx; pw = 1; }
    auto decode = [&](int q, TItem& T) -> bool {
        const int r = F.wave + NWAVES * (q / pw), p = q % pw; const int d = r * ptot + pbase + p;
        if (r * ptot >= NITEMS_P0) return false;
        tr_decode(F, d < NITEMS_P0 ? tr_p0_index(d) : -1, T);
        return true;
    };
    TItem Tc, Tn; float vc[32], vn[32];
    bool have = decode(0, Tc);
    if (have && Tc.item >= 0) p0_item_load(Tc, vc, F.lane);
    for (int q = 0; have; ++q) {
        const bool hn = decode(q + 1, Tn);
        if (hn && Tn.item >= 0) p0_item_load(Tn, vn, F.lane);
        if (Tc.item >= 0) p0_item_store(Tc, vc, scr, F.lane);
        Tc = Tn; have = hn;
#pragma unroll
        for (int i = 0; i < 32; ++i) vc[i] = vn[i];
    }
}
template <bool HSRC16, bool HDST16> __device__ __forceinline__ void norm_phase(Frame& F, const void* h, const bf16* y, void* hdst, const float* g1, const float* sh1, const float* sc1, int st1, bf16* o1,
                                           const float* g2, const float* sh2, const float* sc2, int st2, bf16* o2) {
    const RowMap rm = norm_rows(F); const int gw = rm.row0, NGW = rm.stride, MEND = rm.end;
    f32x4 a1[8], s1[8], a2[8], s2[8]; int bcur = -1;
    f32x4 hf[8]; v2u hh[8], yv[8];
#define NP_ISSUE(r_) do { if (HSRC16) { const GAS v2u* hr_ = (const GAS v2u*)((const bf16*)h + (size_t)(r_) * D) + F.lane; _Pragma("unroll") for (int j = 0; j < 8; ++j) hh[j] = __builtin_nontemporal_load(hr_ + 64 * j); } \
        else { const GAS f32x4* hr_ = (const GAS f32x4*)((const float*)h + (size_t)(r_) * D) + F.lane; _Pragma("unroll") for (int j = 0; j < 8; ++j) hf[j] = __builtin_nontemporal_load(hr_ + 64 * j); } \
        if (y) { const GAS v2u* yr_ = (const GAS v2u*)(y + (size_t)(r_) * D) + F.lane; _Pragma("unroll") for (int j = 0; j < 8; ++j) yv[j] = __builtin_nontemporal_load(yr_ + 64 * j); } } while (0)
    if (gw < MEND) NP_ISSUE(gw);
    for (int row = gw; row < MEND; row += NGW) {
        const int b = row / SEQ;
        f32x4 v[8]; float s = 0.f;
        if (HSRC16) {
#pragma unroll
            for (int j = 0; j < 8; ++j) { v[j].x = h2f((unsigned short)(hh[j].x & 0xffffu)); v[j].y = h2f((unsigned short)(hh[j].x >> 16)); v[j].z = h2f((unsigned short)(hh[j].y & 0xffffu)); v[j].w = h2f((unsigned short)(hh[j].y >> 16)); } }
        else {
#pragma unroll
            for (int j = 0; j < 8; ++j) v[j] = hf[j]; }
        if (y) {
#pragma unroll
            for (int j = 0; j < 8; ++j) { v[j].x += h2f((unsigned short)(yv[j].x & 0xffffu)); v[j].y += h2f((unsigned short)(yv[j].x >> 16)); v[j].z += h2f((unsigned short)(yv[j].y & 0xffffu)); v[j].w += h2f((unsigned short)(yv[j].y >> 16)); } }
        if (row + NGW < MEND) NP_ISSUE(row + NGW);
        if (y) {
            if (HDST16) { GAS v2u* hw = (GAS v2u*)((bf16*)hdst + (size_t)row * D) + F.lane;
#pragma unroll
                for (int j = 0; j < 8; ++j) { v2u w; w.x = pkh(v[j].x, v[j].y); w.y = pkh(v[j].z, v[j].w); __builtin_nontemporal_store(w, hw + 64 * j); } }
            else { GAS f32x4* hw = (GAS f32x4*)((float*)hdst + (size_t)row * D) + F.lane;
#pragma unroll
                for (int j = 0; j < 8; ++j) hw[64 * j] = v[j]; } }
        if (b != bcur) { bcur = b;
            const GAS f32x4* gp = (const GAS f32x4*)g1 + F.lane; const GAS f32x4* sp = (const GAS f32x4*)(sh1 + (size_t)b * st1) + F.lane; const GAS f32x4* cp = (const GAS f32x4*)(sc1 + (size_t)b * st1) + F.lane;
#pragma unroll
            for (int j = 0; j < 8; ++j) { a1[j] = gp[64 * j] * (cp[64 * j] + 1.0f); s1[j] = sp[64 * j]; }
            if (o2) { const GAS f32x4* gq = (const GAS f32x4*)g2 + F.lane; const GAS f32x4* sq = (const GAS f32x4*)(sh2 + (size_t)b * st2) + F.lane; const GAS f32x4* cq = (const GAS f32x4*)(sc2 + (size_t)b * st2) + F.lane;
#pragma unroll
                for (int j = 0; j < 8; ++j) { a2[j] = gq[64 * j] * (cq[64 * j] + 1.0f); s2[j] = sq[64 * j]; } }
        }
#pragma unroll
        for (int j = 0; j < 8; ++j) s += (v[j].x * v[j].x + v[j].y * v[j].y) + (v[j].z * v[j].z + v[j].w * v[j].w);
        const float rstd = 1.0f / sqrtf(wave_sum(s) * (1.f / D) + EPS);
        {   GAS v2u* op = (GAS v2u*)(o1 + (size_t)row * D) + F.lane;
#pragma unroll
            for (int j = 0; j < 8; ++j) { const f32x4 y_ = (v[j] * rstd) * a1[j] + s1[j]; v2u w; w.x = pk2(y_.x, y_.y); w.y = pk2(y_.z, y_.w); op[64 * j] = w; } }
        if (o2) { GAS v2u* op = (GAS v2u*)(o2 + (size_t)row * D) + F.lane;
#pragma unroll
            for (int j = 0; j < 8; ++j) { const f32x4 y_ = (v[j] * rstd) * a2[j] + s2[j]; v2u w; w.x = pk2(y_.x, y_.y); w.y = pk2(y_.z, y_.w); op[64 * j] = w; } }
    }
#undef NP_ISSUE
}
__device__ __forceinline__ void sw_phase(Frame& F) {
    constexpr int R1 = 4 * D, R2 = R1 + NFF, R3 = R2 + 2 * KVD, R4 = R3 + NFF, R5 = R4 + D, NR = R5 + NFF;
    const int gw = blockIdx.x * NWAVES + F.wave, NGW = F.G * NWAVES, per = (NR + NGW - 1) / NGW;
    const int r0 = gw * per, r1 = (r0 + per < NR) ? r0 + per : NR;
    float* SW = (float*)(F.ws + WS_SW);
    const float* mod0 = (const float*)(F.ws + WS_MOD0); const float* mod1 = (const float*)(F.ws + WS_MOD1); const float* kvmod = (const float*)(F.ws + WS_KVMOD);
    f32x4 sh[4][4][2]; int ccur = -1;
    for (int R = r0; R < r1; ++R) {
        int cons, n, N; const bf16* W; const float* shp; int shst; float* outp;
        if (R < R1) { cons = 0; n = R; N = 4 * D; W = (const bf16*)(F.ws + WS_WHI); shp = mod0 + 3 * D; shst = 9 * D; outp = SW + SWO_HI; }
        else if (R < R2) { cons = 1; n = R - R1; N = NFF; W = (const bf16*)(F.ws + WS_WFI + 1 * SZ_WFI); shp = mod0 + 6 * D; shst = 9 * D; outp = SW + SWO_F1; }
        else if (R < R3) { cons = 2; n = R - R2; N = 2 * KVD; W = (const bf16*)(F.ws + WS_WKV); shp = kvmod; shst = 2 * D; outp = SW + SWO_KV; }
        else if (R < R4) { cons = 3; n = R - R3; N = NFF; W = (const bf16*)(F.ws + WS_WFI + 2 * SZ_WFI); shp = mod1; shst = 9 * D; outp = SW + SWO_F2; }
        else if (R < R5) { cons = 4; n = R - R4; N = D; W = (const bf16*)(F.ws + WS_WQ); shp = mod1 + 3 * D; shst = 9 * D; outp = SW + SWO_Q; }
        else { cons = 5; n = R - R5; N = NFF; W = (const bf16*)(F.ws + WS_WFI + 3 * SZ_WFI); shp = mod1 + 6 * D; shst = 9 * D; outp = SW + SWO_F3; }
        const v4u* wr = (const v4u*)(W + (size_t)n * D) + F.lane;
        v4u wv[4];
#pragma unroll
        for (int j = 0; j < 4; ++j) wv[j] = wr[64 * j];
        if (cons != ccur) { ccur = cons;
#pragma unroll
            for (int b = 0; b < 4; ++b)
#pragma unroll
                for (int j = 0; j < 4; ++j) { const f32x4* sp = (const f32x4*)(shp + (size_t)b * shst + 8 * F.lane + 512 * j); sh[b][j][0] = sp[0]; sh[b][j][1] = sp[1]; } }
        float a[4] = {0.f, 0.f, 0.f, 0.f};
#pragma unroll
        for (int j = 0; j < 4; ++j) { const float w0 = bf2f((unsigned short)(wv[j].x & 0xffffu)), w1 = bf2f((unsigned short)(wv[j].x >> 16)), w2 = bf2f((unsigned short)(wv[j].y & 0xffffu)), w3 = bf2f((unsigned short)(wv[j].y >> 16)),
                w4 = bf2f((unsigned short)(wv[j].z & 0xffffu)), w5 = bf2f((unsigned short)(wv[j].z >> 16)), w6 = bf2f((unsigned short)(wv[j].w & 0xffffu)), w7 = bf2f((unsigned short)(wv[j].w >> 16));
#pragma unroll
            for (int b = 0; b < 4; ++b) { const f32x4 s0 = sh[b][j][0], s1 = sh[b][j][1]; a[b] += (w0 * s0.x + w1 * s0.y) + (w2 * s0.z + w3 * s0.w) + (w4 * s1.x + w5 * s1.y) + (w6 * s1.z + w7 * s1.w); } }
#pragma unroll
        for (int b = 0; b < 4; ++b) { const float t = wave_sum(a[b]); if (F.lane == 0) outp[(size_t)b * N + n] = t; }
    }
}
template <bool HSRC16> __device__ __forceinline__ void final_norm_phase(Frame& F, float* h, const bf16* h16, const bf16* y, const float* g) {
    const RowMap rm = norm_rows(F); const int gw = rm.row0, NGW = rm.stride, MEND = rm.end;
    f32x4 gv[8]; { const GAS f32x4* gp = (const GAS f32x4*)g + F.lane;
#pragma unroll
        for (int j = 0; j < 8; ++j) gv[j] = gp[64 * j]; }
    f32x4 hf[8]; v2u hh[8], yv[8];
#define FN_ISSUE(r_) do { if (HSRC16) { const GAS v2u* h6_ = (const GAS v2u*)(h16 + (size_t)(r_) * D) + F.lane; _Pragma("unroll") for (int j = 0; j < 8; ++j) hh[j] = __builtin_nontemporal_load(h6_ + 64 * j); } \
        else { const GAS f32x4* hr_ = (const GAS f32x4*)(h + (size_t)(r_) * D) + F.lane; _Pragma("unroll") for (int j = 0; j < 8; ++j) hf[j] = hr_[64 * j]; } \
        if (y) { const GAS v2u* yr_ = (const GAS v2u*)(y + (size_t)(r_) * D) + F.lane; _Pragma("unroll") for (int j = 0; j < 8; ++j) yv[j] = __builtin_nontemporal_load(yr_ + 64 * j); } } while (0)
    if (gw < MEND) FN_ISSUE(gw);
    for (int row = gw; row < MEND; row += NGW) {
        f32x4 v[8]; float s = 0.f;
        if (HSRC16) {
#pragma unroll
            for (int j = 0; j < 8; ++j) { v[j].x = h2f((unsigned short)(hh[j].x & 0xffffu)); v[j].y = h2f((unsigned short)(hh[j].x >> 16)); v[j].z = h2f((unsigned short)(hh[j].y & 0xffffu)); v[j].w = h2f((unsigned short)(hh[j].y >> 16)); } }
        else {
#pragma unroll
            for (int j = 0; j < 8; ++j) v[j] = hf[j]; }
#pragma unroll
        for (int j = 0; j < 8; ++j) { if (y) { v[j].x += h2f((unsigned short)(yv[j].x & 0xffffu)); v[j].y += h2f((unsigned short)(yv[j].x >> 16)); v[j].z += h2f((unsigned short)(yv[j].y & 0xffffu)); v[j].w += h2f((unsigned short)(yv[j].y >> 16)); }
            s += (v[j].x * v[j].x + v[j].y * v[j].y) + (v[j].z * v[j].z + v[j].w * v[j].w); }
        if (row + NGW < MEND) FN_ISSUE(row + NGW);
        const float rstd = 1.0f / sqrtf(wave_sum(s) * (1.f / D) + EPS);
        GAS f32x4* hw = (GAS f32x4*)(h + (size_t)row * D) + F.lane;
#pragma unroll
        for (int j = 0; j < 8; ++j) __builtin_nontemporal_store((v[j] * rstd) * gv[j], hw + 64 * j);
    }
#undef FN_ISSUE
}

namespace hg {
typedef short bf16x8 __attribute__((ext_vector_type(8)));
typedef short s16x4 __attribute__((ext_vector_type(4)));
typedef float f32x16 __attribute__((ext_vector_type(16)));
typedef float f32x2_t __attribute__((ext_vector_type(2))); typedef __bf16 bf16x2_t __attribute__((ext_vector_type(2)));
__device__ __forceinline__ unsigned cvtpk(float lo, float hi) { f32x2_t v = {lo, hi}; bf16x2_t b = __builtin_convertvector(v, bf16x2_t); return __builtin_bit_cast(unsigned, b); }
__device__ __forceinline__ s16x4 vtr(const LAS unsigned char* p) { return __builtin_bit_cast(s16x4, __builtin_amdgcn_ds_read_tr16_b64_v4i16((LAS s16x4*)p)); }
#define HG_MFMA(a, b, c) __builtin_amdgcn_mfma_f32_32x32x16_bf16((a), (b), (c), 0, 0, 0)
#define HG_BAR() do { asm volatile("s_waitcnt lgkmcnt(0)" ::: "memory"); __builtin_amdgcn_s_barrier(); asm volatile("" ::: "memory"); } while (0)
constexpr int CH = 32, SEGT = 512, NSEG = SEQ / SEGT, NCH = SEGT / CH, NUNIT = BATCH * HH * NSEG, NPAIR = NUNIT / 2;
constexpr int QT_ST = 272, KH_ST = 80, V_ST = 320, OUT_ST = 528;
constexpr int OFF_QT = 0, OFF_KT = OFF_QT + 32 * QT_ST, OFF_KH = OFF_KT + 32 * QT_ST, OFF_V = OFF_KH + 128 * KH_ST, OFF_OUT = OFF_V + 32 * V_ST, OFF_PL = OFF_OUT + 32 * OUT_ST, OFF_RK = OFF_PL + 512, OFF_RQ = OFF_RK + 32 * QT_ST, OFF_HG = OFF_RQ + 32 * QT_ST, GRP_BYTES = OFF_HG + 512;
static_assert(2 * GRP_BYTES <= RING_BYTES && OFF_KT % 16 == 0 && OFF_KH % 16 == 0 && OFF_V % 16 == 0 && OFF_OUT % 16 == 0 && OFF_PL % 16 == 0 && OFF_RK % 16 == 0 && OFF_RQ % 16 == 0 && GRP_BYTES % 16 == 0, "hgrn LDS map");

struct Raw { v4u vp[2]; v4u gp[2]; };
struct RawKQ { v4u kp[2]; v4u qp[2]; };
template <bool OUT> __device__ __forceinline__ void load_raw(Raw& R, const unsigned short* X, int c, int gt) {
#pragma unroll
    for (int j = 0; j < 2; ++j) { const int p = gt + 256 * j, s = p >> 4, c16 = p & 15; R.vp[j] = *(const GAS v4u*)(X + (size_t)(32 * c + s) * 8192 + 4096 + 8 * c16); }
    if (OUT) { const int trow = gt >> 3, vg = gt & 7;
#pragma unroll
        for (int j = 0; j < 2; ++j) R.gp[j] = *(const GAS v4u*)(X + (size_t)(32 * c + trow) * 8192 + 6144 + 16 * vg + 8 * j); }
}
template <bool OUT> __device__ __forceinline__ void load_kq(RawKQ& R, const unsigned short* X, int c, int gt) {
#pragma unroll
    for (int j = 0; j < 2; ++j) { const int p = gt + 256 * j, s = p >> 4, c16 = p & 15; const unsigned short* xp = X + (size_t)(32 * c + s) * 8192 + 8 * c16;
        R.kp[j] = *(const GAS v4u*)(xp + 2048); if (OUT) R.qp[j] = *(const GAS v4u*)xp; }
}
template <bool OUT> __device__ __forceinline__ void store_kq(const RawKQ& R, LAS unsigned char* L, int gt) {
#pragma unroll
    for (int j = 0; j < 2; ++j) { const int p = gt + 256 * j, s = p >> 4, c16 = p & 15;
        *(LAS v4u*)(L + OFF_RK + s * QT_ST + 16 * c16) = R.kp[j]; if (OUT) *(LAS v4u*)(L + OFF_RQ + s * QT_ST + 16 * c16) = R.qp[j]; }
}

template <bool OUT> __device__ __forceinline__ void hgrn_pair(Frame& F, int pair, const unsigned short* QKVG, float* HS, float* HDp, unsigned short* OG) {
    const int grp = F.wave >> 2, vt = F.wave & 3, gt = F.tid & 255, lane = F.lane, l31 = lane & 31, h = lane >> 5;
    const int unit = 2 * pair + grp, seg = unit % NSEG, bh = unit / NSEG, b = bh / HH, hh = bh % HH;
    LAS unsigned char* L = F.lds + RING_OFF + grp * GRP_BYTES;
    const unsigned short* X = QKVG + (size_t)(b * SEQ + seg * SEGT) * 8192 + hh * HK;
    const int pk = gt >> 1, ph = gt & 1;
    f32x16 S[4];
#pragma unroll
    for (int kt = 0; kt < 4; ++kt)
#pragma unroll
        for (int r = 0; r < 16; ++r) S[kt][r] = 0.f;
    if (OUT) {
        for (int j = 0; j < seg; ++j) {
            const int uj = bh * NSEG + j;
            const float* Uj = HS + (size_t)((uj * 4 + vt) * 4) * 1024 + lane * 16;
            const float* Dj = HDp + (size_t)uj * 128 + 4 * h;
#pragma unroll
            for (int kt = 0; kt < 4; ++kt)
#pragma unroll
                for (int g = 0; g < 4; ++g) { const f32x4 u4 = *(const GAS f32x4*)(Uj + kt * 1024 + 4 * g); const f32x4 d4 = *(const GAS f32x4*)(Dj + 32 * kt + 8 * g);
#pragma unroll
                    for (int e = 0; e < 4; ++e) S[kt][4 * g + e] = d4[e] * S[kt][4 * g + e] + u4[e]; }
        }
    }
    float Dtot = 1.f;
    const int trow = gt >> 3, vg = gt & 7;
    if (OUT) { if (gt < 128) *(LAS float*)(L + OFF_HG + 4 * gt) = *(const GAS float*)(F.hgain + hh * HK + gt); }
    Raw rA, rB; RawKQ pA, pB;
    load_kq<OUT>(pA, X, 0, gt); load_raw<OUT>(rA, X, 0, gt);
    store_kq<OUT>(pA, L, gt);
    load_kq<OUT>(pA, X, 1, gt);
    HG_BAR();
    auto chunk = [&](const int c, Raw& cur, Raw& nxt, RawKQ& P1, RawKQ& P2) __attribute__((always_inline)) {
        if (c + 2 < NCH) load_kq<OUT>(P2, X, c + 2, gt);
        if (c + 1 < NCH) load_raw<OUT>(nxt, X, c + 1, gt);
        float kk[16], P[16]; float run = 1.f;
#pragma unroll
        for (int i = 0; i < 16; ++i) { kk[i] = (float)__builtin_bit_cast(_Float16, *(const LAS unsigned short*)(L + OFF_RK + (16 * ph + i) * QT_ST + 2 * pk)); run *= (1.f - kk[i]); P[i] = run; }
        const float oth = __shfl_xor(run, 1);
        const float Pprev = ph ? oth : 1.f, Plast = run * oth;
        if (ph == 0) *(LAS float*)(L + OFF_PL + 4 * pk) = Plast;
        Dtot *= Plast;
        float kh[16];
#pragma unroll
        for (int i = 0; i < 16; ++i) { const float p = P[i] * Pprev; const float rp = __builtin_amdgcn_rcpf(fmaxf(p, 1e-30f)); const float ktl = kk[i] * rp; kh[i] = ktl * Plast;
            if (OUT) { *(LAS unsigned short*)(L + OFF_KT + (16 * ph + i) * QT_ST + 2 * pk) = (unsigned short)cvtpk(ktl, 0.f);
                       *(LAS unsigned short*)(L + OFF_QT + (16 * ph + i) * QT_ST + 2 * pk) = (unsigned short)cvtpk(bf2f(*(const LAS unsigned short*)(L + OFF_RQ + (16 * ph + i) * QT_ST + 2 * pk)) * p, 0.f); } }
        { v4u w0, w1; w0.x = cvtpk(kh[0], kh[1]); w0.y = cvtpk(kh[2], kh[3]); w0.z = cvtpk(kh[4], kh[5]); w0.w = cvtpk(kh[6], kh[7]);
          w1.x = cvtpk(kh[8], kh[9]); w1.y = cvtpk(kh[10], kh[11]); w1.z = cvtpk(kh[12], kh[13]); w1.w = cvtpk(kh[14], kh[15]);
          *(LAS v4u*)(L + OFF_KH + pk * KH_ST + 32 * ph) = w0; *(LAS v4u*)(L + OFF_KH + pk * KH_ST + 32 * ph + 16) = w1; }
#pragma unroll
        for (int j = 0; j < 2; ++j) { const int p = gt + 256 * j, s = p >> 4, c16 = p & 15; *(LAS v4u*)(L + OFF_V + s * V_ST + 16 * c16) = cur.vp[j]; }
        HG_BAR();
        if (c + 1 < NCH) store_kq<OUT>(P1, L, gt);
        f32x16 o;
        if (OUT) {
            f32x16 x;
#pragma unroll
            for (int r = 0; r < 16; ++r) { x[r] = 0.f; o[r] = 0.f; }
#pragma unroll
            for (int ks = 0; ks < 8; ++ks) { const bf16x8 a = *(const LAS bf16x8*)(L + OFF_KT + l31 * QT_ST + 32 * ks + 16 * h); const bf16x8 bq = *(const LAS bf16x8*)(L + OFF_QT + l31 * QT_ST + 32 * ks + 16 * h);
                x = HG_MFMA(a, bq, x); }
#pragma unroll
            for (int r = 0; r < 16; ++r) { const int s = (r & 3) + 8 * (r >> 2) + 4 * h; x[r] = (s <= l31) ? x[r] : 0.f; }
#pragma unroll
            for (int ks2 = 0; ks2 < 2; ++ks2) {
                v4u xp; xp.x = cvtpk(x[8 * ks2 + 0], x[8 * ks2 + 1]); xp.y = cvtpk(x[8 * ks2 + 2], x[8 * ks2 + 3]); xp.z = cvtpk(x[8 * ks2 + 4], x[8 * ks2 + 5]); xp.w = cvtpk(x[8 * ks2 + 6], x[8 * ks2 + 7]);
                const LAS unsigned char* vb = L + OFF_V + (16 * ks2 + 4 * h + ((lane >> 2) & 3)) * V_ST + 2 * (32 * vt + 16 * ((lane >> 4) & 1) + 4 * (lane & 3));
                const s16x4 lo = vtr(vb), hi = vtr(vb + 8 * V_ST);
                const bf16x8 vfrag = __builtin_shufflevector(lo, hi, 0, 1, 2, 3, 4, 5, 6, 7);
                o = HG_MFMA(__builtin_bit_cast(bf16x8, xp), vfrag, o); }
#pragma unroll
            for (int kt = 0; kt < 4; ++kt)
#pragma unroll
                for (int ks2 = 0; ks2 < 2; ++ks2) {
                    v4u sp; sp.x = cvtpk(S[kt][8 * ks2 + 0], S[kt][8 * ks2 + 1]); sp.y = cvtpk(S[kt][8 * ks2 + 2], S[kt][8 * ks2 + 3]); sp.z = cvtpk(S[kt][8 * ks2 + 4], S[kt][8 * ks2 + 5]); sp.w = cvtpk(S[kt][8 * ks2 + 6], S[kt][8 * ks2 + 7]);
                    const LAS unsigned char* qb = L + OFF_QT + l31 * QT_ST + 2 * (32 * kt + 16 * ks2 + 4 * h);
                    const s16x4 lo = *(const LAS s16x4*)qb, hi = *(const LAS s16x4*)(qb + 16);
                    const bf16x8 qfrag = __builtin_shufflevector(lo, hi, 0, 1, 2, 3, 4, 5, 6, 7);
                    o = HG_MFMA(qfrag, __builtin_bit_cast(bf16x8, sp), o); }
        }
        {   bf16x8 vfr[2];
#pragma unroll
            for (int ks2 = 0; ks2 < 2; ++ks2) { const LAS unsigned char* vb = L + OFF_V + (16 * ks2 + 8 * h + ((lane >> 2) & 3)) * V_ST + 2 * (32 * vt + 16 * ((lane >> 4) & 1) + 4 * (lane & 3));
                const s16x4 lo = vtr(vb), hi = vtr(vb + 4 * V_ST); vfr[ks2] = __builtin_shufflevector(lo, hi, 0, 1, 2, 3, 4, 5, 6, 7); }
#pragma unroll
            for (int kt = 0; kt < 4; ++kt) {
#pragma unroll
                for (int g = 0; g < 4; ++g) { const f32x4 d4 = *(const LAS f32x4*)(L + OFF_PL + 4 * (32 * kt + 8 * g + 4 * h));
#pragma unroll
                    for (int e = 0; e < 4; ++e) S[kt][4 * g + e] *= d4[e]; }
#pragma unroll
                for (int ks2 = 0; ks2 < 2; ++ks2) { const bf16x8 a = *(const LAS bf16x8*)(L + OFF_KH + (32 * kt + l31) * KH_ST + 32 * ks2 + 16 * h); S[kt] = HG_MFMA(a, vfr[ks2], S[kt]); } }
        }
        if (OUT) {
#pragma unroll
            for (int r = 0; r < 16; ++r) { const int t = (r & 3) + 8 * (r >> 2) + 4 * h; *(LAS float*)(L + OFF_OUT + t * OUT_ST + 4 * (32 * vt + l31)) = o[r]; }
        }
        HG_BAR();
        if (OUT) {
            f32x4 ov[4]; float ss = 0.f;
#pragma unroll
            for (int e = 0; e < 4; ++e) { ov[e] = *(const LAS f32x4*)(L + OFF_OUT + trow * OUT_ST + 64 * vg + 16 * e); ss += (ov[e].x * ov[e].x + ov[e].y * ov[e].y) + (ov[e].z * ov[e].z + ov[e].w * ov[e].w); }
            ss += __shfl_xor(ss, 1); ss += __shfl_xor(ss, 2); ss += __shfl_xor(ss, 4);
            const float rstd = 1.0f / sqrtf(ss * (1.f / 128.f) + EPS);
            v4u w[2];
#pragma unroll
            for (int j = 0; j < 2; ++j) { const v4u gq = cur.gp[j]; const f32x4 a = ov[2 * j] * rstd * *(const LAS f32x4*)(L + OFF_HG + 64 * vg + 32 * j), bq = ov[2 * j + 1] * rstd * *(const LAS f32x4*)(L + OFF_HG + 64 * vg + 32 * j + 16);
                w[j].x = cvtpk(a.x * bf2f((unsigned short)(gq.x & 0xffffu)), a.y * bf2f((unsigned short)(gq.x >> 16))); w[j].y = cvtpk(a.z * bf2f((unsigned short)(gq.y & 0xffffu)), a.w * bf2f((unsigned short)(gq.y >> 16)));
                w[j].z = cvtpk(bq.x * bf2f((unsigned short)(gq.z & 0xffffu)), bq.y * bf2f((unsigned short)(gq.z >> 16))); w[j].w = cvtpk(bq.z * bf2f((unsigned short)(gq.w & 0xffffu)), bq.w * bf2f((unsigned short)(gq.w >> 16))); }
            unsigned short* op = OG + (size_t)(b * SEQ + seg * SEGT + 32 * c + trow) * D + hh * HK + 16 * vg;
            *(GAS v4u*)op = w[0]; *(GAS v4u*)(op + 8) = w[1];
        }
    };
#pragma unroll 1
    for (int c = 0; c < NCH; c += 2) { chunk(c, rA, rB, pA, pB); chunk(c + 1, rB, rA, pB, pA); }
    if (!OUT) {
        float* Uo = HS + (size_t)((unit * 4 + vt) * 4) * 1024 + lane * 16;
#pragma unroll
        for (int kt = 0; kt < 4; ++kt)
#pragma unroll
            for (int g = 0; g < 4; ++g) *(GAS f32x4*)(Uo + kt * 1024 + 4 * g) = (f32x4){S[kt][4 * g], S[kt][4 * g + 1], S[kt][4 * g + 2], S[kt][4 * g + 3]};
        if (ph == 0) *(GAS float*)(HDp + (size_t)unit * 128 + pk) = Dtot;
    }
}
template <bool OUT> __device__ __forceinline__ void hgrn_phase(Frame& F, const unsigned short* QKVG, float* HS, float* HDp, unsigned short* OG) {
    static_assert(NPAIR == 256, "pair numbering");
    const bool loc = frame_pm(F) >= 0;
    for (int p0 = blockIdx.x; p0 < NPAIR; p0 += F.G) { const int pair = loc ? ((p0 & 63) * 4 + (p0 >> 6)) : p0; hgrn_pair<OUT>(F, pair, QKVG, HS, HDp, OG); HG_BAR(); }
}
}

namespace at {
using hg::bf16x8; using hg::s16x4; using hg::f32x16; using hg::cvtpk; using hg::vtr;
constexpr int K_ST = 144, V_ST = 192;
template <int NQB> struct Lay { static constexpr int KEYS = (NQB + 1) * WIN, OFF_K = 0, OFF_V = KEYS * K_ST, BYTES = OFF_V + KEYS * V_ST; };
constexpr int NBLK = SEQ / WIN, NUNIT = BATCH * NBLK * NKV;
static_assert(Lay<2>::BYTES <= RING_BYTES && Lay<1>::OFF_V % 16 == 0 && Lay<2>::OFF_V % 16 == 0, "attention LDS map");
template <int NQB> __device__ __forceinline__ void attn_unit(Frame& F, int unit, const unsigned short* Q, const unsigned short* K, const unsigned short* V, unsigned short* O) {
    constexpr int OFF_K = Lay<NQB>::OFF_K, OFF_V = Lay<NQB>::OFF_V, KEYS = Lay<NQB>::KEYS;
    const int kvh = unit % NKV, n = (unit / NKV) % NBLK, b = unit / (NKV * NBLK);
    LAS unsigned char* L = F.lds + RING_OFF;
    const int lane = F.lane, l31 = lane & 31, h = lane >> 5;
    for (int p = F.tid; p < KEYS * 8; p += NWAVES * 64) { const int r = p >> 3, c8 = p & 7, srow = (n - 1) * WIN + r;
        v4u kv = {0u, 0u, 0u, 0u}, vv = {0u, 0u, 0u, 0u};
        if (srow >= 0) { const size_t go = (size_t)(b * SEQ + srow) * KVD + kvh * HD + 8 * c8; kv = *(const GAS v4u*)(K + go); vv = *(const GAS v4u*)(V + go); }
        *(LAS v4u*)(L + OFF_K + r * K_ST + 16 * c8) = kv; *(LAS v4u*)(L + OFF_V + r * V_ST + 16 * c8) = vv; }
    HG_BAR();
    const int qh = kvh * 8 + F.wave;
    const float sink2 = *(const GAS float*)(F.sinks + qh) * 1.4426950408889634f;
    const unsigned short* Qb = Q + (size_t)(b * SEQ + n * WIN + l31) * D + qh * HD + 8 * h;
    bf16x8 qn[4];
#pragma unroll
    for (int ks = 0; ks < 4; ++ks) qn[ks] = *(const GAS bf16x8*)(Qb + 16 * ks);
#pragma unroll 1
    for (int qt = 0; qt < 4 * NQB; ++qt) {
        bf16x8 qf[4];
#pragma unroll
        for (int ks = 0; ks < 4; ++ks) qf[ks] = qn[ks];
        if (qt < 4 * NQB - 1) {
#pragma unroll
            for (int ks = 0; ks < 4; ++ks) qn[ks] = *(const GAS bf16x8*)(Qb + (size_t)(32 * (qt + 1)) * D + 16 * ks); }
        f32x16 x[5];
#pragma unroll
        for (int i = 0; i < 5; ++i) {
#pragma unroll
            for (int r = 0; r < 16; ++r) x[i][r] = 0.f;
#pragma unroll
            for (int ks = 0; ks < 4; ++ks) { const bf16x8 a = *(const LAS bf16x8*)(L + OFF_K + (32 * (qt + i) + l31) * K_ST + 32 * ks + 16 * h); x[i] = HG_MFMA(a, qf[ks], x[i]); } }
        float mx = sink2;
        if (n == 0 && qt < 4) {
#pragma unroll
            for (int i = 0; i < 4; ++i)
#pragma unroll
                for (int r = 0; r < 16; ++r) { const int cr = (r & 3) + 8 * (r >> 2) + 4 * h; if (32 * (qt + i) + cr < WIN) x[i][r] = -INFINITY; }
        }
#pragma unroll
        for (int r = 0; r < 16; ++r) { const int cr = (r & 3) + 8 * (r >> 2) + 4 * h; x[0][r] = (cr > l31) ? x[0][r] : -INFINITY; x[4][r] = (cr <= l31) ? x[4][r] : -INFINITY; }
#pragma unroll
        for (int i = 0; i < 5; ++i)
#pragma unroll
            for (int r = 0; r < 16; ++r) mx = fmaxf(mx, x[i][r]);
        mx = fmaxf(mx, __shfl_xor(mx, 32));
        float sum = 0.f;
#pragma unroll
        for (int i = 0; i < 5; ++i)
#pragma unroll
            for (int r = 0; r < 16; ++r) { const float p = __builtin_amdgcn_exp2f(x[i][r] - mx); x[i][r] = p; sum += p; }
        sum += __shfl_xor(sum, 32);
        sum += __builtin_amdgcn_exp2f(sink2 - mx);
        const float inv = 1.0f / sum;
        f32x16 o[2];
#pragma unroll
        for (int r = 0; r < 16; ++r) { o[0][r] = 0.f; o[1][r] = 0.f; }
#pragma unroll
        for (int i = 0; i < 5; ++i)
#pragma unroll
            for (int ks2 = 0; ks2 < 2; ++ks2) {
                v4u pp; pp.x = cvtpk(x[i][8 * ks2 + 0], x[i][8 * ks2 + 1]); pp.y = cvtpk(x[i][8 * ks2 + 2], x[i][8 * ks2 + 3]);
                pp.z = cvtpk(x[i][8 * ks2 + 4], x[i][8 * ks2 + 5]); pp.w = cvtpk(x[i][8 * ks2 + 6], x[i][8 * ks2 + 7]);
#pragma unroll
                for (int dt = 0; dt < 2; ++dt) {
                    const LAS unsigned char* vb = L + OFF_V + (32 * (qt + i) + 16 * ks2 + 4 * h + ((lane >> 2) & 3)) * V_ST + 2 * (32 * dt + 16 * ((lane >> 4) & 1) + 4 * (lane & 3));
                    const s16x4 lo = vtr(vb), hi = vtr(vb + 8 * V_ST);
                    o[dt] = HG_MFMA(__builtin_shufflevector(lo, hi, 0, 1, 2, 3, 4, 5, 6, 7), __builtin_bit_cast(bf16x8, pp), o[dt]); } }
        unsigned short* orow = O + (size_t)(b * SEQ + n * WIN + 32 * qt + l31) * D + qh * HD + 4 * h;
#pragma unroll
        for (int dt = 0; dt < 2; ++dt)
#pragma unroll
            for (int g = 0; g < 4; ++g) { v2u w; w.x = cvtpk(o[dt][4 * g + 0] * inv, o[dt][4 * g + 1] * inv); w.y = cvtpk(o[dt][4 * g + 2] * inv, o[dt][4 * g + 3] * inv);
                *(GAS v2u*)(orow + 32 * dt + 8 * g) = w; }
    }
}
__device__ __forceinline__ void attn_phase(Frame& F, const unsigned short* Q, const unsigned short* K, const unsigned short* V, unsigned short* O) {
    const int pm_ = frame_pm(F);
    if (pm_ >= 0) {
        { const int b = pm_ / (SEQ / 256), n = 2 * (pm_ % (SEQ / 256)); attn_unit<2>(F, (b * NBLK + n) * NKV + frame_q(F), Q, K, V, O); HG_BAR(); }
        return; }
    for (int unit = blockIdx.x; unit < NUNIT; unit += F.G) { attn_unit<1>(F, unit, Q, K, V, O); HG_BAR(); }
}
}
constexpr int N_PHASES = 24;
constexpr int SIG_B = 0, SIG_KVC = 1, SIG_KVG = 2, SIG_C = 3, SIG_D = 4, SIG_MOD = 5;
constexpr int PROBE_K = -1, PROBE_N = 2;
#define REPK(k) ((k) == PROBE_K ? PROBE_N : 1)
struct Args { const float* in[21]; float* out; unsigned char* ws; int ph_lo, ph_hi, li, pad; };
__global__ void __launch_bounds__(NWAVES * 64, 2) mega_fwd(Args args) {
    extern __shared__ __attribute__((aligned(16))) unsigned char lds[];
    Frame F;
    F.lds = (LAS unsigned char*)lds; F.MISC = (volatile LAS unsigned*)(F.lds + MISC_OFF);
    F.tid = threadIdx.x; F.lane = F.tid & 63; F.wave = __builtin_amdgcn_readfirstlane(F.tid >> 6); F.G = gridDim.x;
    F.ws = args.ws; F.out = args.out; F.ctl = (gu32*)(args.ws + WS_CTL);
    F.x = args.in[0]; F.c = args.in[1]; F.norm_gain = args.in[2]; F.w_ada = args.in[3]; F.b_ada = args.in[4]; F.w_ffn_in = args.in[5]; F.w_ffn_out = args.in[6]; F.w_hgrn_in = args.in[7];
    F.lb_logits = args.in[8]; F.hgain = args.in[9]; F.w_hgrn_out = args.in[10]; F.kv_gain = args.in[11]; F.w_ada_kv = args.in[12]; F.b_ada_kv = args.in[13]; F.w_kv = args.in[14]; F.b_kv = args.in[15];
    F.w_q = args.in[16]; F.b_q = args.in[17]; F.sinks = args.in[18]; F.w_ao = args.in[19]; F.final_gain = args.in[20];
    for (int u = F.tid; u < (LDS_BYTES - LDSCTL_OFF) / 4; u += NWAVES * 64) ((LAS unsigned*)(F.lds + LDSCTL_OFF))[u] = 0u;
    __syncthreads();
    XcdBarrier bar = xcd_barrier_post((unsigned*)(F.ctl + CW_BAR) + args.li * XCD_BAR_WORDS, F.MISC + 8);
    if (threadIdx.x == 0 && F.G == 256 && args.pad == 1) { const unsigned c = blockIdx.x; F.MISC[11] = 1u + 8u * (c & 7u) + ((c >> 3) & 7u); F.MISC[12] = c >> 6; }
    __syncthreads();
    if (threadIdx.x == 0 && (F.G != 256 || args.pad != 1 || bar.x != (blockIdx.x & 7u))) (void)xb_add(&bar.bar[XB_MISMATCH], 1u);
    const int lo = args.ph_lo, hi = args.ph_hi;
#define IN(k) (lo <= (k) && (k) < hi)
#define SEAM(k) do { if (IN(k) && IN((k) + 1)) xcd_barrier(bar); } while (0)
#define SEAMS(k, sig, n) do { if (IN(k) && IN((k) + 1)) grp_barrier(bar, (sig), (n)); } while (0)
#define SEAML(k) do { if (IN(k) && IN((k) + 1)) grp_barrier(bar); } while (0)
#define REPEAT(n) _Pragma("nounroll") for (int _r = 0; _r < (n); ++_r, (_r < (n) ? xcd_barrier(bar) : (void)0))
#define mod0 ((const float*)(ws + WS_MOD0))
#define mod1 ((const float*)(ws + WS_MOD1))
#define kvmod ((const float*)(ws + WS_KVMOD))
#define U ((bf16*)(ws + WS_U))
#define UKV ((bf16*)(ws + WS_UKV))
#define HID ((bf16*)(ws + WS_HID))
#define QKVG ((bf16*)(ws + WS_QKVG))
#define OG ((bf16*)(ws + WS_OG))
#define QB ((bf16*)(ws + WS_Q))
#define KB ((bf16*)(ws + WS_K))
#define VB ((bf16*)(ws + WS_V))
#define sint ((const float*)(ws + WS_SIN))
#define cost ((const float*)(ws + WS_COS))
    constexpr int MS = 9 * D;
#define PH_BEGIN unsigned char* ws = args.ws; asm volatile("" : "+s"(ws)); { int _t = threadIdx.x; asm volatile("" : "+v"(_t)); F.tid = _t; F.lane = _t & 63; F.wave = __builtin_amdgcn_readfirstlane(_t >> 6); } int bx = __builtin_amdgcn_readfirstlane((int)blockIdx.x); asm volatile("" : "+s"(bx));
#define YB ((bf16*)(ws + WS_Y))
#define H16 ((bf16*)(ws + WS_H16))
constexpr bool RES16 = true;
#define NOFIX pg8::NormFix{nullptr, nullptr, 0, 0.f, 0.f}
#define FFN_IN(f) do { pg8::Gemm g{U, (const bf16*)(ws + WS_WFI + (f) * SZ_WFI), M, NFF, D, 2 * D, 128, 2 * D, 128, -1}; pg8::StaticOrder S; S.init(M, NFF, F.G, bx); pg8::EpiSwiGLU<false> E{HID, M, NOFIX}; \
        pg8::gemm_phase<pg8::EpiSwiGLU<false>, pg8::StaticOrder, true, true>(F.lds + RING_OFF, g, S, E); } while (0)
#define FFN_OUT(f, mod, sub) do { pg8::Gemm g{HID, (const bf16*)(ws + WS_WFO + (f) * SZ_WFO), M, D, DFF, 128, 128 * M, 128, 128 * D, -1}; pg8::StaticOrder S; S.init(M, D, F.G, bx); \
        pg8::EpiY<true> E{YB, D, (mod) + ((sub) * 3 + 2) * D, MS}; pg8::gemm_phase<pg8::EpiY<true>, pg8::StaticOrder, true, true>(F.lds + RING_OFF, g, S, E); } while (0)
#define FFN_OUT_R(f, mod, sub, SRC32_) do { pg8::Gemm g{HID, (const bf16*)(ws + WS_WFO + (f) * SZ_WFO), M, D, DFF, 128, 128 * M, 128, 128 * D, -1}; pg8::StaticOrder S; S.init(M, D, F.G, bx); \
        pg8::EpiYR<true, SRC32_> E{H16, F.x, D, (mod) + ((sub) * 3 + 2) * D, MS}; pg8::gemm_phase<pg8::EpiYR<true, SRC32_>, pg8::StaticOrder, true, true>(F.lds + RING_OFF, g, S, E); } while (0)
#define PROJ_OUT_R(A_, W_, mod) do { pg8::Gemm g{(A_), (const bf16*)(ws + (W_)), M, D, D, 2 * D, 128, 2 * D, 128, -1}; pg8::StaticOrder S; S.init(M, D, F.G, bx); \
        pg8::EpiYR<false, false> E{H16, F.x, D, (mod) + (1 * 3 + 2) * D, MS}; pg8::gemm_phase<pg8::EpiYR<false, false>, pg8::StaticOrder, true, true>(F.lds + RING_OFF, g, S, E); } while (0)
#define NORM16(layer, sub, mod) norm_phase<true, true>(F, (const void*)H16, nullptr, nullptr, F.norm_gain + (size_t)((layer) * 3 + (sub)) * D, (mod) + ((sub) * 3 + 0) * D, (mod) + ((sub) * 3 + 1) * D, MS, U, nullptr, nullptr, nullptr, 0, nullptr)
#define PROJ_OUT(A_, W_, mod) do { pg8::Gemm g{(A_), (const bf16*)(ws + (W_)), M, D, D, 2 * D, 128, 2 * D, 128, -1}; pg8::StaticOrder S; S.init(M, D, F.G, bx); \
        pg8::EpiY<false> E{YB, D, (mod) + (1 * 3 + 2) * D, MS}; pg8::gemm_phase<pg8::EpiY<false>, pg8::StaticOrder, true, true>(F.lds + RING_OFF, g, S, E); } while (0)
#define ADDNORM(S16, hsrc, layer, sub, mod) norm_phase<S16, RES16>(F, (hsrc), YB, RES16 ? (void*)H16 : (void*)F.out, F.norm_gain + (size_t)((layer) * 3 + (sub)) * D, (mod) + ((sub) * 3 + 0) * D, (mod) + ((sub) * 3 + 1) * D, MS, U, nullptr, nullptr, nullptr, 0, nullptr)

    if (IN(0)) { PH_BEGIN; p0_prologue(F, bar, SIG_MOD); }
    if (IN(0) && IN(1)) xb_wait(bar, SIG_MOD, (unsigned)F.G);
    if (IN(1)) { PH_BEGIN; if (F.G != 256) tr_deferred(F, 0, NDEF, 0, F.G);
        norm_phase<false, false>(F, F.x, nullptr, nullptr, F.norm_gain + 0 * D, mod0 + 0 * D, mod0 + 1 * D, MS, U, nullptr, nullptr, nullptr, 0, nullptr); }
    SEAM(1);
    if (IN(1) && IN(2) && threadIdx.x == 0) F.MISC[10] = (xb_ld(&bar.bar[XB_MISMATCH]) == 0u) ? 1u : 0u;
    if (IN(2)) { PH_BEGIN; FFN_IN(0); if (F.G == 256 && bx >= 192) tr_deferred(F, SLOT_A_LO, SLOT_A_HI, 192, 64); }
    SEAML(2);
    if (IN(3)) { PH_BEGIN; FFN_OUT_R(0, mod0, 0, true); }
    SEAML(3);
    if (IN(4)) { PH_BEGIN; NORM16(0, 1, mod0); }
    SEAML(4);
    if (IN(5)) { PH_BEGIN; { pg8::Gemm g{U, (const bf16*)(ws + WS_WHI), M, 4 * D, D, 2 * D, 128, 2 * D, 128, -1}; pg8::StaticOrder S; S.init(M, 4 * D, F.G, bx); pg8::EpiHgrn<false> E{QKVG, (const float*)(ws + WS_LB), NOFIX};
        pg8::gemm_phase<pg8::EpiHgrn<false>, pg8::StaticOrder, true, true>(F.lds + RING_OFF, g, S, E); } }
    SEAM(5);
    if (IN(6)) { PH_BEGIN; REPEAT(REPK(6)) hg::hgrn_phase<false>(F, QKVG, (float*)(ws + WS_HS), (float*)(ws + WS_HD), OG); }
    SEAML(6);
    if (IN(7)) { PH_BEGIN; REPEAT(REPK(7)) hg::hgrn_phase<true>(F, QKVG, (float*)(ws + WS_HS), (float*)(ws + WS_HD), OG); }
    SEAM(7);
    if (IN(8)) { PH_BEGIN; PROJ_OUT_R(OG, WS_WHO, mod0); }
    SEAML(8);
    if (IN(9)) { PH_BEGIN; NORM16(0, 2, mod0); }
    SEAML(9);
    if (IN(10)) { PH_BEGIN; FFN_IN(1); if (F.G == 256 && bx >= 192) { tr_deferred(F, SLOT_A_HI, SLOT_B_HI, 192, 64); xb_signal(bar, SIG_B); } }
    SEAML(10);
    if (IN(11)) { PH_BEGIN; FFN_OUT_R(1, mod0, 2, false); }
    SEAML(11);
    if (IN(12)) { PH_BEGIN; norm_phase<true, true>(F, (const void*)H16, nullptr, nullptr, F.norm_gain + (size_t)(1 * 3 + 0) * D, mod1 + 0 * D, mod1 + 1 * D, MS, U, F.kv_gain, kvmod, kvmod + D, 2 * D, UKV); }
    SEAML(12);
    if (IN(13)) { PH_BEGIN; { pg8::Gemm g{UKV, (const bf16*)(ws + WS_WKV), M, 2 * KVD, D, 2 * D, 128, 2 * D, 128, -1}; pg8::StaticOrder S; S.init(M, 2 * KVD, F.G, bx);
        pg8::EpiRope<false> E{KB, VB, KVD, KVD, F.b_kv, sint, cost, 1.0f, 1, NOFIX};
        pg8::gemm_phase<pg8::EpiRope<false>, pg8::StaticOrder, true, true>(F.lds + RING_OFF, g, S, E); }
        if (F.G == 256) { if (bx >= 128) { tr_deferred(F, SLOT_KV_LO, SLOT_KV_HI, 128, 128); xb_signal(bar, SIG_KVC); } else xb_signal(bar, SIG_KVG); } }
    SEAMS(13, SIG_KVC, 128u);
    if (IN(14)) { PH_BEGIN; FFN_IN(2); if (F.G == 256 && bx >= 192) { tr_deferred(F, SLOT_B_HI, SLOT_C_HI, 192, 64); xb_signal(bar, SIG_C); } }
    SEAML(14);
    if (IN(15)) { PH_BEGIN; FFN_OUT_R(2, mod1, 0, false); }
    SEAML(15);
    if (IN(16)) { PH_BEGIN; NORM16(1, 1, mod1); }
    SEAMS(16, SIG_C, 64u);
    if (IN(17)) { PH_BEGIN; { pg8::Gemm g{U, (const bf16*)(ws + WS_WQ), M, D, D, 2 * D, 128, 2 * D, 128, -1}; pg8::StaticOrder S; S.init(M, D, F.G, bx);
        pg8::EpiRope<false> E{QB, QB, 1 << 30, D, F.b_q, sint, cost, QSCALE, 1 << 30, NOFIX};
        pg8::gemm_phase<pg8::EpiRope<false>, pg8::StaticOrder, true, true>(F.lds + RING_OFF, g, S, E); } }
    SEAMS(17, SIG_KVG, 128u);
    if (IN(18)) { PH_BEGIN; REPEAT(REPK(18)) at::attn_phase(F, QB, KB, VB, OG); }
    SEAML(18);
    if (IN(19)) { PH_BEGIN; PROJ_OUT_R(OG, WS_WAO, mod1); }
    SEAML(19);
    if (IN(20)) { PH_BEGIN; NORM16(1, 2, mod1); }
    SEAMS(20, SIG_B, 64u);
    if (IN(21)) { PH_BEGIN; FFN_IN(3); if (F.G == 256 && bx >= 192) { tr_deferred(F, SLOT_C_HI, SLOT_D_HI, 192, 64); xb_signal(bar, SIG_D); } }
    SEAMS(21, SIG_D, 64u);
    if (IN(22)) { PH_BEGIN; FFN_OUT_R(3, mod1, 2, false); }
    SEAML(22);
    if (IN(23)) { PH_BEGIN; final_norm_phase<true>(F, F.out, H16, nullptr, F.final_gain); }
#undef IN
#undef SEAM
#undef SEAML
#undef SEAMS
#undef YB
#undef H16
#undef mod0
#undef mod1
#undef kvmod
#undef U
#undef UKV
#undef HID
#undef QKVG
#undef OG
#undef QB
#undef KB
#undef VB
#undef sint
#undef cost
}

extern "C" void kernel_launch(void* const* d_in, const int* in_sizes, int n_in, void* d_out, int out_size, void* d_ws, size_t ws_size, hipStream_t stream) {
    static int grid = 0;
    if (grid == 0) {
        if (n_in != 21 || in_sizes[0] != M * D || out_size != M * D || ws_size < WS_END) { fprintf(stderr, "kernel_launch: unexpected shapes (n_in %d, in0 %d, out %d, ws %zu < %zu)\n", n_in, n_in > 0 ? in_sizes[0] : -1, out_size, ws_size, (size_t)WS_END); grid = -1; return; }
        int dev = 0, cus = 0, per_cu = 0;
        if (hipGetDevice(&dev) != hipSuccess || hipDeviceGetAttribute(&cus, hipDeviceAttributeMultiprocessorCount, dev) != hipSuccess) { grid = -1; return; }
        if (hipFuncSetAttribute((const void*)mega_fwd, hipFuncAttributeMaxDynamicSharedMemorySize, LDS_BYTES) != hipSuccess) { fprintf(stderr, "kernel_launch: hipFuncSetAttribute failed\n"); grid = -1; return; }
        if (hipOccupancyMaxActiveBlocksPerMultiprocessor(&per_cu, (const void*)mega_fwd, NWAVES * 64, LDS_BYTES) != hipSuccess || per_cu < 1) fprintf(stderr, "kernel_launch: occupancy query reports %d\n", per_cu);
        (void)hipGetLastError();
        grid = cus;
    }
    if (grid < 0) return;
    if (hipMemsetAsync((char*)d_ws + WS_CTL, 0, CTL_ZERO_BYTES, stream) != hipSuccess) return;
    static int panel_ok = -1;
    if (panel_ok < 0) {
        panel_ok = (grid == 256) ? 1 : 0;
        const int shapes[4] = {NFF, D, 4 * D, 2 * KVD};
        for (int sI = 0; sI < 4 && panel_ok; ++sI) for (int c = 0; c < 256 && panel_ok; ++c) { pg8::StaticOrder S; S.init(M, shapes[sI], 256, c); pg8::Unit u;
            for (int i = 0; S.next(i, u); ++i) if (u.pm != 8 * (c & 7) + ((c >> 3) & 7)) { panel_ok = 0; break; } }
    }
    Args a{};
    a.pad = panel_ok;
    for (int i = 0; i < 21; ++i) a.in[i] = (const float*)d_in[i];
    a.out = (float*)d_out; a.ws = (unsigned char*)d_ws;
    auto launch = [&](int lo, int hi, int li) { a.ph_lo = lo; a.ph_hi = hi; a.li = li; hipLaunchKernelGGL(mega_fwd, dim3(grid), dim3(NWAVES * 64), LDS_BYTES, stream, a); };
    launch(0, N_PHASES, 0);
}
```

```cpp
#include <hip/hip_runtime.h>
#include <cstdio>
#include <cstdint>
namespace pg8 {
#define PG8_LAS __attribute__((address_space(3)))
typedef unsigned short bf16_t;
typedef short bf16x8 __attribute__((ext_vector_type(8)));
typedef float f32x4 __attribute__((ext_vector_type(4)));
typedef unsigned u32x4 __attribute__((ext_vector_type(4)));
constexpr int BM = 256, BK = 64, HALF = 128, HTB = HALF * BK * 2  , STAGE_BYTES = 8 * HTB, NXCD = 8, WGM = 8;

__host__ __device__ __forceinline__ int lds_byte(int r, int c) { const int st = (r >> 4) * 2 + (c >> 5), rr = r & 15, cc = c & 31, ob = rr * 64 + cc * 2; return st * 1024 + (ob ^ (((ob >> 9) & 1) << 5)); }
__host__ __device__ __forceinline__ void stage_rc(int b, int& R, int& C) { const int st = b / 1024, sb = b % 1024, swz = sb ^ (((sb >> 9) & 1) << 5); R = (st >> 1) * 16 + swz / 64; C = (st & 1) * 32 + (swz % 64) / 2; }
__host__ __device__ __forceinline__ int perm32(int rho) { const int n = rho >> 4, i = rho & 15; return 8 * (i >> 2) + 4 * n + (i & 3); }

struct Unit { int pm, pn; };
struct Gemm { const bf16_t* A; const bf16_t* Bt; int M, N, K; int rsA, ksA, rsB, ksB; int opmask; };

struct StaticOrder {
    int nM, nN, nwg, G, c;
    __host__ __device__ void init(int M, int N, int G_, int c_) { nM = M / BM; nN = N / BM; nwg = nM * nN; G = G_; c = c_; }
    __host__ __device__ bool next(int i, Unit& u) const {
        const long L = (long)i * G + c; if (L >= nwg) return false;
        int wgid = (int)L; { const int q = nwg / NXCD, r = nwg % NXCD, xcd = wgid % NXCD, off = wgid / NXCD; wgid = (xcd < r ? xcd * (q + 1) : r * (q + 1) + (xcd - r) * q) + off; }
        const int nig = WGM * nN, gid = wgid / nig, fm = gid * WGM, gsz = (nM - fm) < WGM ? (nM - fm) : WGM;
        u.pm = fm + ((wgid % nig) % gsz); u.pn = (wgid % nig) / gsz; return true;
    }
    __device__ __forceinline__ void a_ready(const Unit&) const {}
    __device__ __forceinline__ void done(const Unit&) const {}
};
__device__ __forceinline__ unsigned cvt_pk_bf16(float lo, float hi) { unsigned r; asm volatile("v_cvt_pk_bf16_f32 %0, %1, %2" : "=v"(r) : "v"(lo), "v"(hi)); return r; }
typedef float f32x2 __attribute__((ext_vector_type(2)));
typedef _Float16 f16x2 __attribute__((ext_vector_type(2)));
__device__ __forceinline__ unsigned cvt_pk_f16(float lo, float hi) { f16x2 v = {(_Float16)lo, (_Float16)hi}; return __builtin_bit_cast(unsigned, v); }
__device__ __forceinline__ float fsigmoid(float x) { return __builtin_amdgcn_rcpf(1.f + __builtin_amdgcn_exp2f(-1.4426950408889634f * x)); }
constexpr int SEQ_ROWS = 4096;


struct NormFix { const float* rowss; const float* sw; int swstride; float invk, eps; };
constexpr int NFX_OFF = STAGE_BYTES + 1024, NFX_BUF = 2048;
__device__ __forceinline__ void normfix_prefetch(const NormFix& nf, PG8_LAS unsigned char* lds, const Unit& u, int par, int wid, int lane) {
    const int b = (u.pm * BM) / SEQ_ROWS;
    const float* gp = (wid < 4) ? nf.rowss + u.pm * BM + 64 * wid + lane : nf.sw + (size_t)b * nf.swstride + u.pn * BM + 64 * (wid - 4) + lane;
    __builtin_amdgcn_global_load_lds((const unsigned*)gp, (PG8_LAS unsigned*)(lds + NFX_OFF + par * NFX_BUF + 256 * wid), 4, 0, 0);
}
__device__ __forceinline__ void normfix_rstd(const NormFix& nf, const PG8_LAS unsigned char* lds, int par, int rloc0, float (&rs)[2][4]) {
    const PG8_LAS float* r = (const PG8_LAS float*)(lds + NFX_OFF + par * NFX_BUF);
#pragma unroll
    for (int ai = 0; ai < 2; ++ai)
#pragma unroll
        for (int m = 0; m < 4; ++m) rs[ai][m] = 1.0f / sqrtf(r[rloc0 + ai * HALF + m * 16] * nf.invk + nf.eps);
}
__device__ __forceinline__ f32x4 normfix_sw(const PG8_LAS unsigned char* lds, int par, int cloc) { return *(const PG8_LAS f32x4*)(lds + NFX_OFF + par * NFX_BUF + 1024 + 4 * cloc); }

template <bool FUSED> struct EpiSwiGLU {
    static constexpr bool PERM = true, AFTER_DRAIN = false;
    bf16_t* O; int rows;
    NormFix nf;
    __device__ __forceinline__ void prefetch(PG8_LAS unsigned char* lds, const Unit& u, int par, int wid, int lane) const { if (FUSED) normfix_prefetch(nf, lds, u, par, wid, lane); }
    __device__ __forceinline__ void operator()(const f32x4 (&acc)[2][2][4][2], const Unit& u, int wr, int wc, int fr, int fq, const PG8_LAS unsigned char* lds, int par) const {
        const int row0 = u.pm * BM + wr * 64 + fr, kb = 2 * u.pn + (wc >> 1), within = 32 * (wc & 1) + 8 * fq;
        float rs[2][4]; f32x4 swv[2][2];
        if (FUSED) { normfix_rstd(nf, lds, par, wr * 64 + fr, rs);
#pragma unroll
            for (int bj = 0; bj < 2; ++bj)
#pragma unroll
                for (int n = 0; n < 2; ++n) swv[bj][n] = normfix_sw(lds, par, wc * 32 + 8 * fq + bj * HALF + 4 * n); }
#pragma unroll
        for (int ai = 0; ai < 2; ++ai)
#pragma unroll
            for (int m = 0; m < 4; ++m) { bf16_t* rowp = O + ((size_t)kb * rows + (row0 + ai * HALF + m * 16)) * 64 + within;
                f32x4 a0 = acc[ai][0][m][0], a1 = acc[ai][0][m][1], b0 = acc[ai][1][m][0], b1 = acc[ai][1][m][1]; f32x4 v0, v1;
                if (FUSED) { const float r = rs[ai][m]; a0 = a0 * r + swv[0][0]; a1 = a1 * r + swv[0][1]; b0 = b0 * r + swv[1][0]; b1 = b1 * r + swv[1][1]; }
                { f32x4 e0, e1;
#pragma unroll
                  for (int j = 0; j < 4; ++j) { e0[j] = __builtin_amdgcn_exp2f(a0[j]); e1[j] = __builtin_amdgcn_exp2f(a1[j]); }
                  e0 = e0 + 1.0f; e1 = e1 + 1.0f;
#pragma unroll
                  for (int j = 0; j < 4; ++j) { e0[j] = __builtin_amdgcn_rcpf(e0[j]); e1[j] = __builtin_amdgcn_rcpf(e1[j]); }
                  v0 = (a0 * b0) * e0; v1 = (a1 * b1) * e1; }
                u32x4 w; w.x = cvt_pk_bf16(v0[0], v0[1]); w.y = cvt_pk_bf16(v0[2], v0[3]); w.z = cvt_pk_bf16(v1[0], v1[1]); w.w = cvt_pk_bf16(v1[2], v1[3]);
                *(__attribute__((address_space(1))) u32x4*)rowp = w; }
    }
};
template <int NOUT, bool HALFSTEP> struct EpiResid {
    static constexpr bool PERM = false, AFTER_DRAIN = false;
    const float* src; float* dst; int ld; const float* gate; int gstride;
    bf16_t* A1; const float* g1p; const float* sc1p; int st1; bf16_t* A2; const float* g2p; const float* sc2p; int st2; float* rowss;
    __device__ __forceinline__ void prefetch(PG8_LAS unsigned char*, const Unit&, int, int, int) const {}
    __device__ __forceinline__ void operator()(const f32x4 (&acc)[2][2][4][2], const Unit& u, int, int, int, int, const PG8_LAS unsigned char*, int) const {
        int tz = threadIdx.x; asm volatile("" : "+v"(tz));
        const int wid = tz >> 6, lane = tz & 63, wr = wid >> 2, wc = wid & 3, fr = lane & 15, fq = lane >> 4;
        const int row0 = u.pm * BM + wr * 64 + fr, col0 = u.pn * BM + wc * 32 + 4 * fq, b = (u.pm * BM) / SEQ_ROWS;
        f32x4 gv[2][2], g1[2][2], g2[2][2];
#pragma unroll
        for (int bj = 0; bj < 2; ++bj)
#pragma unroll
            for (int n = 0; n < 2; ++n) { const int c = col0 + bj * HALF + n * 16; gv[bj][n] = *(const __attribute__((address_space(1))) f32x4*)(gate + (size_t)b * gstride + c) * (HALFSTEP ? 0.5f : 1.0f);
                if (NOUT >= 1) g1[bj][n] = *(const f32x4*)(g1p + c) * (*(const f32x4*)(sc1p + (size_t)b * st1 + c) + 1.0f);
                if (NOUT >= 2) g2[bj][n] = *(const f32x4*)(g2p + c) * (*(const f32x4*)(sc2p + (size_t)b * st2 + c) + 1.0f); }
        constexpr int MB = (NOUT == 0) ? 4 : (NOUT == 1 ? 2 : 1);
#pragma unroll
        for (int ai = 0; ai < 2; ++ai)
#pragma unroll
        for (int m0 = 0; m0 < 4; m0 += MB) {
            f32x4 s[MB][2][2];
#pragma unroll
            for (int mm = 0; mm < MB; ++mm) { const size_t off = (size_t)(row0 + ai * HALF + (m0 + mm) * 16) * ld + col0;
#pragma unroll
                for (int bj = 0; bj < 2; ++bj)
#pragma unroll
                    for (int n = 0; n < 2; ++n) s[mm][bj][n] = *(const f32x4*)(src + off + bj * HALF + n * 16); }
#pragma unroll
            for (int mm = 0; mm < MB; ++mm) { const int m = m0 + mm, row = row0 + ai * HALF + m * 16; const size_t off = (size_t)row * ld + col0; float ss = 0.f;
#pragma unroll
                for (int bj = 0; bj < 2; ++bj)
#pragma unroll
                    for (int n = 0; n < 2; ++n) { const f32x4 hn = s[mm][bj][n] + gv[bj][n] * acc[ai][bj][m][n]; *(f32x4*)(dst + off + bj * HALF + n * 16) = hn;
                        if (NOUT >= 1) { ss += (hn.x * hn.x + hn.y * hn.y) + (hn.z * hn.z + hn.w * hn.w); const f32x4 y = hn * g1[bj][n];
                            typedef unsigned u32x2 __attribute__((ext_vector_type(2))); u32x2 w; w.x = cvt_pk_bf16(y.x, y.y); w.y = cvt_pk_bf16(y.z, y.w); *(u32x2*)(A1 + off + bj * HALF + n * 16) = w; }
                        if (NOUT >= 2) { const f32x4 y = hn * g2[bj][n];
                            typedef unsigned u32x2 __attribute__((ext_vector_type(2))); u32x2 w; w.x = cvt_pk_bf16(y.x, y.y); w.y = cvt_pk_bf16(y.z, y.w); *(u32x2*)(A2 + off + bj * HALF + n * 16) = w; } }
                if (NOUT >= 1) { ss += __shfl_xor(ss, 16); ss += __shfl_xor(ss, 32);
                    if (fq == 0) (void)__hip_atomic_fetch_add(rowss + row, ss, __ATOMIC_RELAXED, __HIP_MEMORY_SCOPE_AGENT); } }
        }
    }
};
template <bool HALFSTEP> struct EpiY {
    static constexpr bool PERM = true, AFTER_DRAIN = false;
    bf16_t* Y; int ld; const float* gate; int gstride;
    __device__ __forceinline__ void prefetch(PG8_LAS unsigned char*, const Unit&, int, int, int) const {}
    __device__ __forceinline__ void operator()(const f32x4 (&acc)[2][2][4][2], const Unit& u, int wr, int wc, int fr, int fq, const PG8_LAS unsigned char*, int) const {
        const int row0 = u.pm * BM + wr * 64 + fr, col0 = u.pn * BM + wc * 32 + 8 * fq, b = (u.pm * BM) / SEQ_ROWS;
        f32x4 gv[2][2];
#pragma unroll
        for (int bj = 0; bj < 2; ++bj)
#pragma unroll
            for (int n = 0; n < 2; ++n) gv[bj][n] = *(const __attribute__((address_space(1))) f32x4*)(gate + (size_t)b * gstride + col0 + bj * HALF + 4 * n) * (HALFSTEP ? 0.5f : 1.0f);
#pragma unroll
        for (int ai = 0; ai < 2; ++ai)
#pragma unroll
            for (int m = 0; m < 4; ++m) { bf16_t* rowp = Y + (size_t)(row0 + ai * HALF + m * 16) * ld + col0;
#pragma unroll
                for (int bj = 0; bj < 2; ++bj) { const f32x4 v0 = acc[ai][bj][m][0] * gv[bj][0], v1 = acc[ai][bj][m][1] * gv[bj][1];
                    u32x4 w; w.x = cvt_pk_f16(v0[0], v0[1]); w.y = cvt_pk_f16(v0[2], v0[3]); w.z = cvt_pk_f16(v1[0], v1[1]); w.w = cvt_pk_f16(v1[2], v1[3]);
                    *(__attribute__((address_space(1))) u32x4*)(rowp + bj * HALF) = w; } }
    }
};
template <bool HALFSTEP, bool SRC32> struct EpiYR {
    static constexpr bool PERM = true, AFTER_DRAIN = false;
    bf16_t* H; const float* X; int ld; const float* gate; int gstride;
    __device__ __forceinline__ void prefetch(PG8_LAS unsigned char*, const Unit&, int, int, int) const {}
    __device__ __forceinline__ void operator()(const f32x4 (&acc)[2][2][4][2], const Unit& u, int wr, int wc, int fr, int fq, const PG8_LAS unsigned char*, int) const {
        const int row0 = u.pm * BM + wr * 64 + fr, col0 = u.pn * BM + wc * 32 + 8 * fq, b = (u.pm * BM) / SEQ_ROWS;
        f32x4 gv[2][2];
#pragma unroll
        for (int bj = 0; bj < 2; ++bj)
#pragma unroll
            for (int n = 0; n < 2; ++n) gv[bj][n] = *(const __attribute__((address_space(1))) f32x4*)(gate + (size_t)b * gstride + col0 + bj * HALF + 4 * n) * (HALFSTEP ? 0.5f : 1.0f);
#pragma unroll
        for (int ai = 0; ai < 2; ++ai) {
            u32x4 r16[4][2]; f32x4 r32[4][2][2];
#pragma unroll
            for (int m = 0; m < 4; ++m)
#pragma unroll
                for (int bj = 0; bj < 2; ++bj) { const size_t off = (size_t)(row0 + ai * HALF + m * 16) * ld + col0 + bj * HALF;
                    if (SRC32) { r32[m][bj][0] = *(const __attribute__((address_space(1))) f32x4*)(X + off); r32[m][bj][1] = *(const __attribute__((address_space(1))) f32x4*)(X + off + 4); }
                    else r16[m][bj] = *(const __attribute__((address_space(1))) u32x4*)(H + off); }
#pragma unroll
            for (int m = 0; m < 4; ++m)
#pragma unroll
                for (int bj = 0; bj < 2; ++bj) { const size_t off = (size_t)(row0 + ai * HALF + m * 16) * ld + col0 + bj * HALF;
                    f32x4 h0, h1;
                    if (SRC32) { h0 = r32[m][bj][0]; h1 = r32[m][bj][1]; }
                    else { const unsigned d0 = r16[m][bj].x, d1 = r16[m][bj].y, d2 = r16[m][bj].z, d3 = r16[m][bj].w;
                        const f16x2 p0 = __builtin_bit_cast(f16x2, d0), p1 = __builtin_bit_cast(f16x2, d1), p2 = __builtin_bit_cast(f16x2, d2), p3 = __builtin_bit_cast(f16x2, d3);
                        h0[0] = (float)p0[0]; h0[1] = (float)p0[1]; h0[2] = (float)p1[0]; h0[3] = (float)p1[1]; h1[0] = (float)p2[0]; h1[1] = (float)p2[1]; h1[2] = (float)p3[0]; h1[3] = (float)p3[1]; }
                    const f32x4 v0 = h0 + acc[ai][bj][m][0] * gv[bj][0], v1 = h1 + acc[ai][bj][m][1] * gv[bj][1];
                    u32x4 w; w.x = cvt_pk_f16(v0[0], v0[1]); w.y = cvt_pk_f16(v0[2], v0[3]); w.z = cvt_pk_f16(v1[0], v1[1]); w.w = cvt_pk_f16(v1[2], v1[3]);
                    *(__attribute__((address_space(1))) u32x4*)(H + off) = w; }
        }
    }
};
template <bool FUSED> struct EpiHgrn {
    static constexpr bool PERM = true, AFTER_DRAIN = false;
    bf16_t* O; const float* lb; NormFix nf;
    __device__ __forceinline__ void prefetch(PG8_LAS unsigned char* lds, const Unit& u, int par, int wid, int lane) const { if (FUSED) normfix_prefetch(nf, lds, u, par, wid, lane); }
    __device__ __forceinline__ void operator()(const f32x4 (&acc)[2][2][4][2], const Unit& u, int wr, int wc, int fr, int fq, const PG8_LAS unsigned char* lds, int par) const {
        const int row0 = u.pm * BM + wr * 64 + fr, col0 = u.pn * BM + wc * 32 + 8 * fq, type = u.pn >> 3;
        float rs[2][4]; f32x4 swv[2][2];
        if (FUSED) { normfix_rstd(nf, lds, par, wr * 64 + fr, rs);
#pragma unroll
            for (int bj = 0; bj < 2; ++bj)
#pragma unroll
                for (int n = 0; n < 2; ++n) swv[bj][n] = normfix_sw(lds, par, wc * 32 + 8 * fq + bj * HALF + 4 * n); }
        f32x4 oml[2][2];
#pragma unroll
        for (int bj = 0; bj < 2; ++bj)
#pragma unroll
            for (int n = 0; n < 2; ++n) { oml[bj][n] = (f32x4){1.f, 1.f, 1.f, 1.f}; if (type == 1) oml[bj][n] = (f32x4){1.f, 1.f, 1.f, 1.f} - *(const __attribute__((address_space(1))) f32x4*)(lb + (col0 - 2048) + bj * HALF + 4 * n); }
#pragma unroll
        for (int ai = 0; ai < 2; ++ai)
#pragma unroll
            for (int m = 0; m < 4; ++m) { bf16_t* rowp = O + (size_t)(row0 + ai * HALF + m * 16) * 8192 + col0;
#pragma unroll
                for (int bj = 0; bj < 2; ++bj) { f32x4 v0 = acc[ai][bj][m][0], v1 = acc[ai][bj][m][1]; u32x4 w;
                    if (FUSED) { v0 = v0 * rs[ai][m] + swv[bj][0]; v1 = v1 * rs[ai][m] + swv[bj][1]; }
                    if (type == 0) {
#pragma unroll
                        for (int j = 0; j < 4; ++j) { v0[j] = v0[j] * fsigmoid(v0[j]); v1[j] = v1[j] * fsigmoid(v1[j]); } }
                    if (type == 1) {
#pragma unroll
                        for (int j = 0; j < 4; ++j) { v0[j] = oml[bj][0][j] * fsigmoid(-v0[j]); v1[j] = oml[bj][1][j] * fsigmoid(-v1[j]); } }
                    if (type == 3) {
#pragma unroll
                        for (int j = 0; j < 4; ++j) { v0[j] = fsigmoid(v0[j]); v1[j] = fsigmoid(v1[j]); } }
                    if (type == 1) { w.x = cvt_pk_f16(v0[0], v0[1]); w.y = cvt_pk_f16(v0[2], v0[3]); w.z = cvt_pk_f16(v1[0], v1[1]); w.w = cvt_pk_f16(v1[2], v1[3]); }
                    else { w.x = cvt_pk_bf16(v0[0], v0[1]); w.y = cvt_pk_bf16(v0[2], v0[3]); w.z = cvt_pk_bf16(v1[0], v1[1]); w.w = cvt_pk_bf16(v1[2], v1[3]); }
                    *(__attribute__((address_space(1))) u32x4*)(rowp + bj * HALF) = w; } }
    }
};
template <bool FUSED> struct EpiRope {
    static constexpr bool PERM = true, AFTER_DRAIN = false;
    bf16_t* O0; bf16_t* O1; int split, ldc; const float* bias; const float* sint; const float* cost; float scale; int rope_tiles; NormFix nf;
    __device__ __forceinline__ void prefetch(PG8_LAS unsigned char* lds, const Unit& u, int par, int wid, int lane) const { if (FUSED) normfix_prefetch(nf, lds, u, par, wid, lane); }
    __device__ __forceinline__ void operator()(const f32x4 (&acc)[2][2][4][2], const Unit& u, int wr, int wc, int fr, int fq, const PG8_LAS unsigned char* lds, int par) const {
        const int row0 = u.pm * BM + wr * 64 + fr; int colt = u.pn * BM; bf16_t* base = O0;
        if (colt >= split) { base = O1; colt -= split; }
        const int col0 = colt + wc * 32 + 8 * fq, bcol0 = u.pn * BM + wc * 32 + 8 * fq;
        const bool dorope = (u.pn < rope_tiles) && ((wc & 1) == 0);
        const float sgn = (fq == 0) ? -1.f : 1.f;
        f32x4 bv[2][2];
#pragma unroll
        for (int bj = 0; bj < 2; ++bj)
#pragma unroll
            for (int n = 0; n < 2; ++n) { bv[bj][n] = *(const __attribute__((address_space(1))) f32x4*)(bias + bcol0 + bj * HALF + 4 * n); if (FUSED) bv[bj][n] += normfix_sw(lds, par, wc * 32 + 8 * fq + bj * HALF + 4 * n); }
        float rs[2][4]; if (FUSED) normfix_rstd(nf, lds, par, wr * 64 + fr, rs);
#pragma unroll
        for (int ai = 0; ai < 2; ++ai)
#pragma unroll
            for (int m = 0; m < 4; ++m) { const int row = row0 + ai * HALF + m * 16, tpos = row % SEQ_ROWS; bf16_t* rowp = base + (size_t)row * ldc + col0;
                f32x4 s0 = {0.f, 0.f, 0.f, 0.f}, s1 = s0, c0 = {1.f, 1.f, 1.f, 1.f}, c1 = c0;
                if (dorope && fq < 2) { s0 = *(const __attribute__((address_space(1))) f32x4*)(sint + tpos * 8); s1 = *(const __attribute__((address_space(1))) f32x4*)(sint + tpos * 8 + 4); c0 = *(const __attribute__((address_space(1))) f32x4*)(cost + tpos * 8); c1 = *(const __attribute__((address_space(1))) f32x4*)(cost + tpos * 8 + 4); }
#pragma unroll
                for (int bj = 0; bj < 2; ++bj) { f32x4 v0 = acc[ai][bj][m][0], v1 = acc[ai][bj][m][1];
                    if (FUSED) { v0 = v0 * rs[ai][m]; v1 = v1 * rs[ai][m]; }
                    v0 += bv[bj][0]; v1 += bv[bj][1];
                    if (dorope) { f32x4 p0, p1;
#pragma unroll
                        for (int j = 0; j < 4; ++j) { p0[j] = __shfl_xor(v0[j], 16); p1[j] = __shfl_xor(v1[j], 16); }
                        v0 = v0 * c0 + (p0 * s0) * sgn; v1 = v1 * c1 + (p1 * s1) * sgn; }
                    v0 = v0 * scale; v1 = v1 * scale;
                    u32x4 w; w.x = cvt_pk_bf16(v0[0], v0[1]); w.y = cvt_pk_bf16(v0[2], v0[3]); w.z = cvt_pk_bf16(v1[0], v1[1]); w.w = cvt_pk_bf16(v1[2], v1[3]);
                    *(__attribute__((address_space(1))) u32x4*)(rowp + bj * HALF) = w; } }
    }
};

template <class Epi, class Sched, bool ALIGN_EPI = false, bool SP2 = false>
__device__ __forceinline__ void gemm_phase(PG8_LAS unsigned char* lds, const Gemm g, const Sched& S, const Epi& E) {
    const int tid = threadIdx.x, wid = __builtin_amdgcn_readfirstlane(tid >> 6), lane = tid & 63, wr = wid >> 2, wc = wid & 3, fr = lane & 15, fq = lane >> 4;
    const int K = g.K, nt = K / BK;
    unsigned voffA[2], voffB[2];
#pragma unroll
    for (int i = 0; i < 2; ++i) { int R, C; stage_rc(tid * 16 + i * 8192, R, C); const int Rb = Epi::PERM ? ((R & ~31) + perm32(R & 31)) : R;
        voffA[i] = (unsigned)(R * g.rsA + C * 2); voffB[i] = (unsigned)(Rb * g.rsB + C * 2); }
    const size_t kstepA = (size_t)g.ksA, kstepB = (size_t)g.ksB;
    const size_t hstepA = (size_t)HALF * g.rsA, hstepB = (size_t)HALF * g.rsB;
    const size_t tstepA = 2 * hstepA, tstepB = 2 * hstepB;
    const unsigned ldsw = (unsigned)wid * 1024u; const unsigned ldsbase = (unsigned)__builtin_amdgcn_readfirstlane((int)((unsigned)(size_t)lds + ldsw));
    const int aoff = lds_byte(wr * 64 + fr, fq * 8), boff = lds_byte(wc * 32 + fr, fq * 8);
#define PG8_SA(b, h) (((b) * 2 + (h)) * HTB)
#define PG8_SB(b, h) ((4 + (b) * 2 + (h)) * HTB)
#define PG8_DMA1(gbase_, voff32_, ldsdst_) do { unsigned _keep; asm volatile("s_mov_b32 %0, m0\n\ts_mov_b32 m0, %3\n\ts_nop 0\n\tglobal_load_lds_dwordx4 %1, %2\n\ts_mov_b32 m0, %0" \
        : "=&s"(_keep) : "v"(voff32_), "s"((unsigned long long)(gbase_)), "s"(ldsdst_) : "memory"); } while (0)
#define PG8_STAGE(bufoff, gbase, voff) do { _Pragma("unroll") for (int _i = 0; _i < 2; ++_i) PG8_DMA1((const char*)(gbase), (voff)[_i], ldsbase + (unsigned)((bufoff) + _i * 8192)); } while (0)
#define PG8_LDA(dst, b, h) do { _Pragma("unroll") for (int m = 0; m < 4; ++m) _Pragma("unroll") for (int k = 0; k < 2; ++k) dst[m][k] = *(const PG8_LAS bf16x8*)(lds + PG8_SA(b, h) + aoff + m * 2048 + k * 1024); } while (0)
#define PG8_LDB(dst, b, h) do { _Pragma("unroll") for (int n = 0; n < 2; ++n) _Pragma("unroll") for (int k = 0; k < 2; ++k) dst[n][k] = *(const PG8_LAS bf16x8*)(lds + PG8_SB(b, h) + boff + n * 2048 + k * 1024); } while (0)
#define PG8_MMA(ai, bj, At, Bt) do { __builtin_amdgcn_s_setprio(1); _Pragma("unroll") for (int m = 0; m < 4; ++m) _Pragma("unroll") for (int n = 0; n < 2; ++n) _Pragma("unroll") for (int k = 0; k < 2; ++k) \
        acc[ai][bj][m][n] = __builtin_amdgcn_mfma_f32_16x16x32_bf16(Bt[n][k], At[m][k], acc[ai][bj][m][n], 0, 0, 0); __builtin_amdgcn_s_setprio(0); } while (0)
#define PG8_WAIT_V(n) asm volatile("s_waitcnt vmcnt(" #n ")" ::: "memory")
#define PG8_WAIT_L(n) asm volatile("s_waitcnt lgkmcnt(" #n ")" ::: "memory")
#define PG8_BAR __builtin_amdgcn_s_barrier()
#define PG8_SCHED __builtin_amdgcn_sched_barrier(0)
    Unit cur, nxt; int ui = 0;
    if (!S.next(0, cur)) return;
    f32x4 acc[2][2][4][2];
#pragma unroll
    for (int a = 0; a < 2; ++a)
#pragma unroll
        for (int b = 0; b < 2; ++b)
#pragma unroll
            for (int m = 0; m < 4; ++m)
#pragma unroll
                for (int n = 0; n < 2; ++n) acc[a][b][m][n] = (f32x4){0.f, 0.f, 0.f, 0.f};
    bf16x8 At[4][2], B0[2][2], B1[2][2];
    const char* cA = (const char*)g.A + (size_t)(cur.pm & g.opmask) * tstepA; const char* cB = (const char*)g.Bt + (size_t)(cur.pn & g.opmask) * tstepB;
    S.a_ready(cur);
    E.prefetch(lds, cur, 0, wid, lane);
    if constexpr (SP2) {
        PG8_STAGE(PG8_SB(0, 0), cB, voffB); PG8_STAGE(PG8_SB(0, 1), cB + hstepB, voffB); PG8_STAGE(PG8_SA(0, 0), cA, voffA); PG8_STAGE(PG8_SA(0, 1), cA + hstepA, voffA);
        PG8_STAGE(PG8_SB(1, 0), cB + kstepB, voffB); PG8_STAGE(PG8_SB(1, 1), cB + hstepB + kstepB, voffB);
        if (wr == 1) PG8_BAR;
        PG8_WAIT_V(4); PG8_BAR; PG8_BAR;
    } else {
        PG8_STAGE(PG8_SB(0, 0), cB, voffB); PG8_STAGE(PG8_SA(0, 0), cA, voffA); PG8_STAGE(PG8_SB(0, 1), cB + hstepB, voffB); PG8_STAGE(PG8_SA(0, 1), cA + hstepA, voffA);
        if (wr == 1) PG8_BAR;
        PG8_WAIT_V(4); PG8_BAR;
        PG8_STAGE(PG8_SB(1, 0), cB + kstepB, voffB); PG8_STAGE(PG8_SA(1, 0), cA + kstepA, voffA); PG8_STAGE(PG8_SB(1, 1), cB + hstepB + kstepB, voffB);
        PG8_WAIT_V(6); PG8_BAR;
    }
    for (;;) {
        const bool has_next = S.next(ui + 1, nxt);
        const char* nA = has_next ? (const char*)g.A + (size_t)(nxt.pm & g.opmask) * tstepA : cA; const char* nB = has_next ? (const char*)g.Bt + (size_t)(nxt.pn & g.opmask) * tstepB : cB;
        for (int t = 0; t < nt; t += 2) {
            const bool last = (t == nt - 2);
            const char* a1 = cA + (size_t)(t + 1) * kstepA;
            const char* a2 = last ? nA : cA + (size_t)(t + 2) * kstepA; const char* b2 = last ? nB : cB + (size_t)(t + 2) * kstepB;
            const char* a3 = a2 + kstepA; const char* b3 = b2 + kstepB;
            if (last && has_next) { S.a_ready(nxt); E.prefetch(lds, nxt, (ui + 1) & 1, wid, lane); }
            if constexpr (SP2) {
            PG8_LDB(B0, 0, 0); PG8_LDB(B1, 0, 1); PG8_SCHED; PG8_LDA(At, 0, 0); PG8_STAGE(PG8_SA(1, 0), a1, voffA); PG8_STAGE(PG8_SA(1, 1), a1 + hstepA, voffA);
            PG8_WAIT_V(8); PG8_WAIT_L(0); PG8_BAR; PG8_MMA(0, 0, At, B0); PG8_MMA(0, 1, At, B1); PG8_BAR; PG8_SCHED;
            PG8_LDA(At, 0, 1); PG8_STAGE(PG8_SB(0, 0), b2, voffB); PG8_STAGE(PG8_SB(0, 1), b2 + hstepB, voffB);
            PG8_WAIT_V(4); PG8_WAIT_L(0); PG8_BAR; PG8_MMA(1, 0, At, B0); PG8_MMA(1, 1, At, B1); PG8_BAR; PG8_SCHED;
            PG8_LDB(B0, 1, 0); PG8_LDB(B1, 1, 1); PG8_SCHED; PG8_LDA(At, 1, 0); PG8_STAGE(PG8_SA(0, 0), a2, voffA); PG8_STAGE(PG8_SA(0, 1), a2 + hstepA, voffA);
            PG8_WAIT_V(8); PG8_WAIT_L(0); PG8_BAR; PG8_MMA(0, 0, At, B0); PG8_MMA(0, 1, At, B1); PG8_BAR; PG8_SCHED;
            PG8_LDA(At, 1, 1); PG8_STAGE(PG8_SB(1, 0), b3, voffB); PG8_STAGE(PG8_SB(1, 1), b3 + hstepB, voffB);
            PG8_WAIT_V(4); PG8_WAIT_L(0); PG8_BAR; PG8_MMA(1, 0, At, B0); PG8_MMA(1, 1, At, B1); PG8_BAR; PG8_SCHED;
            } else {
            PG8_LDB(B0, 0, 0); PG8_SCHED; PG8_LDA(At, 0, 0); PG8_STAGE(PG8_SA(1, 1), a1 + hstepA, voffA);
            PG8_WAIT_L(8); PG8_BAR; PG8_WAIT_L(0); PG8_MMA(0, 0, At, B0); PG8_BAR; PG8_SCHED;
            PG8_LDB(B1, 0, 1); PG8_STAGE(PG8_SB(0, 0), b2, voffB);
            PG8_BAR; PG8_WAIT_L(0); PG8_MMA(0, 1, At, B1); PG8_BAR;
            PG8_LDA(At, 0, 1); PG8_STAGE(PG8_SA(0, 0), a2, voffA);
            PG8_BAR; PG8_WAIT_L(0); PG8_MMA(1, 0, At, B0); PG8_BAR; PG8_SCHED;
            PG8_STAGE(PG8_SB(0, 1), b2 + hstepB, voffB);
            PG8_WAIT_V(6); PG8_BAR; PG8_MMA(1, 1, At, B1); PG8_BAR;
            PG8_LDB(B0, 1, 0); PG8_SCHED; PG8_LDA(At, 1, 0); PG8_STAGE(PG8_SA(0, 1), a2 + hstepA, voffA);
            PG8_WAIT_L(8); PG8_BAR; PG8_WAIT_L(0); PG8_MMA(0, 0, At, B0); PG8_BAR; PG8_SCHED;
            PG8_LDB(B1, 1, 1); PG8_STAGE(PG8_SB(1, 0), b3, voffB);
            PG8_BAR; PG8_WAIT_L(0); PG8_MMA(0, 1, At, B1); PG8_BAR;
            PG8_LDA(At, 1, 1); PG8_STAGE(PG8_SA(1, 0), a3, voffA);
            PG8_BAR; PG8_WAIT_L(0); PG8_MMA(1, 0, At, B0); PG8_BAR; PG8_SCHED;
            PG8_STAGE(PG8_SB(1, 1), b3 + hstepB, voffB);
            PG8_WAIT_V(6); PG8_BAR; PG8_MMA(1, 1, At, B1); PG8_BAR;
            }
        }
        if constexpr (ALIGN_EPI) { if (wr == 0) PG8_BAR; }
        if constexpr (!Epi::AFTER_DRAIN) { E(acc, cur, wr, wc, fr, fq, lds, ui & 1); S.done(cur); }
        if (!has_next) break;
#pragma unroll
        for (int a = 0; a < 2; ++a)
#pragma unroll
            for (int b = 0; b < 2; ++b)
#pragma unroll
                for (int m = 0; m < 4; ++m)
#pragma unroll
                    for (int n = 0; n < 2; ++n) acc[a][b][m][n] = (f32x4){0.f, 0.f, 0.f, 0.f};
        cur = nxt; cA = nA; cB = nB; ++ui;
        if constexpr (ALIGN_EPI) { if (wr == 1) PG8_BAR; }
    }
    PG8_WAIT_V(0);
    if constexpr (!ALIGN_EPI) { if (wr == 0) PG8_BAR; }
    PG8_BAR;
    if constexpr (Epi::AFTER_DRAIN) { E.fused(acc, cur, wr, wc, fr, fq, lds, wid, lane); S.done(cur); }
#undef PG8_SA
#undef PG8_SB
#undef PG8_STAGE
#undef PG8_LDA
#undef PG8_LDB
#undef PG8_MMA
#undef PG8_WAIT_V
#undef PG8_WAIT_L
#undef PG8_BAR
#undef PG8_SCHED
}
}

constexpr int BATCH = 4, SEQ = 4096, M = BATCH * SEQ, D = 2048, DFF = 5504, NFF = 2 * DFF;
constexpr int HH = 16, HK = 128;
constexpr int NQ = 32, NKV = 4, HD = 64, WIN = 128, KVD = NKV * HD;
constexpr float EPS = 1e-6f;
constexpr float QSCALE = 0.125f * 1.4426950408889634f;
constexpr int NWAVES = 8;
static_assert(SEQ == pg8::SEQ_ROWS, "SEQ");

constexpr size_t MiB = 1u << 20;
constexpr size_t WS_CTL = 0, CTL_ZERO_BYTES = 64 * 1024;
constexpr size_t WS_MOD0 = 1 * MiB, WS_MOD1 = WS_MOD0 + (size_t)BATCH * 9 * D * 4, WS_KVMOD = WS_MOD1 + (size_t)BATCH * 9 * D * 4, WS_LB = WS_KVMOD + (size_t)BATCH * 2 * D * 4,
                 WS_SIN = WS_LB + (size_t)D * 4, WS_COS = WS_SIN + (size_t)SEQ * 8 * 4, WS_SMALL_END = WS_COS + (size_t)SEQ * 8 * 4;
static_assert(WS_SMALL_END <= 2 * MiB, "small region");
constexpr size_t SZ_WFI = (size_t)NFF * D * 2, SZ_WFO = (size_t)D * DFF * 2;
constexpr size_t WS_WFI = 2 * MiB, WS_WFO = WS_WFI + 4 * SZ_WFI, WS_WHI = WS_WFO + 4 * SZ_WFO, WS_WHO = WS_WHI + (size_t)4 * D * D * 2, WS_WKV = WS_WHO + (size_t)D * D * 2,
                 WS_WQ = WS_WKV + 2 * MiB, WS_WAO = WS_WQ + (size_t)D * D * 2, WS_U = WS_WAO + (size_t)D * D * 2, WS_UKV = WS_U + (size_t)M * D * 2, WS_HID = WS_UKV + (size_t)M * D * 2,
                 WS_QKVG = WS_HID + (size_t)M * DFF * 2, WS_OG = WS_QKVG + (size_t)M * 4 * D * 2, WS_Q = WS_OG + (size_t)M * D * 2, WS_K = WS_Q + (size_t)M * D * 2, WS_V = WS_K + (size_t)M * KVD * 2,
                 WS_HS = WS_V + (size_t)M * KVD * 2, WS_HD = WS_HS + (size_t)BATCH * HH * 8 * HK * HK * 4, WS_SW = WS_HD + 1 * MiB, WS_Y = WS_SW + 1 * MiB, WS_H16 = WS_Y + (size_t)M * D * 2, WS_END = WS_H16 + (size_t)M * D * 2;
static_assert(WS_WFI % MiB == 0 && WS_WFO % MiB == 0 && WS_WHI % MiB == 0 && WS_U % MiB == 0 && WS_HID % MiB == 0 && WS_QKVG % MiB == 0 && WS_HS % MiB == 0, "ws alignment");
constexpr int CW_TMO = 0, CW_CODE = 1, CW_BAR = 4096;
constexpr int CW_ROWSS = 32768, N_ROWSS = 5;
static_assert((size_t)(CW_BAR + 3 * 3456) * 4 <= CTL_ZERO_BYTES, "barrier words inside the memset region");
constexpr int SWO_HI = 0, SWO_F1 = SWO_HI + 4 * 4 * D, SWO_KV = SWO_F1 + 4 * NFF, SWO_F2 = SWO_KV + 4 * 2 * KVD, SWO_Q = SWO_F2 + 4 * NFF, SWO_F3 = SWO_Q + 4 * D, SWO_END = SWO_F3 + 4 * NFF;
static_assert((size_t)SWO_END * 4 <= MiB, "sw region");

constexpr int RING_OFF = 0, RING_BYTES = 147456, LDSCTL_OFF = RING_BYTES, MISC_OFF = LDSCTL_OFF + 320, LDS_BYTES = 149504;

#define GAS __attribute__((address_space(1)))
#define LAS __attribute__((address_space(3)))
typedef unsigned short bf16;
typedef unsigned v4u __attribute__((ext_vector_type(4)));
typedef unsigned v2u __attribute__((ext_vector_type(2)));
typedef float f32x4 __attribute__((ext_vector_type(4)));
typedef GAS unsigned gu32;
#define RLX_AGENT __ATOMIC_RELAXED, __HIP_MEMORY_SCOPE_AGENT
#define LDS_WAIT() asm volatile("s_waitcnt lgkmcnt(0)" ::: "memory")
#define VM_WAIT() asm volatile("s_waitcnt vmcnt(0)" ::: "memory")
__device__ __forceinline__ unsigned f2bf(float f) { unsigned u = __builtin_bit_cast(unsigned, f); return (u + 0x7fffu + ((u >> 16) & 1u)) >> 16; }
__device__ __forceinline__ unsigned pk2(float lo, float hi) { return f2bf(lo) | (f2bf(hi) << 16); }
__device__ __forceinline__ float bf2f(unsigned short b) { return __builtin_bit_cast(float, ((unsigned)b) << 16); }
__device__ __forceinline__ float h2f(unsigned short b) { return (float)__builtin_bit_cast(_Float16, b); }
typedef _Float16 f16x2_t __attribute__((ext_vector_type(2)));
__device__ __forceinline__ unsigned pkh(float lo, float hi) { f16x2_t v = {(_Float16)lo, (_Float16)hi}; return __builtin_bit_cast(unsigned, v); }
#define XB_TMO      128
#define XB_XCNT(j)  (256  + 64 * (j))
#define XB_XSUB(j)  (1280 + 64 * (j))
#define XB_XGEN(j)  (2304 + 64 * (j))
#define XB_TOP      3328
#define XB_TOPGEN   3392
#define XCD_BAR_WORDS 3456
#define XB_SPIN_CAP (1u << 18)

__device__ __forceinline__ unsigned xb_ld(unsigned* p)              { return __hip_atomic_load(p, __ATOMIC_RELAXED, __HIP_MEMORY_SCOPE_AGENT); }
__device__ __forceinline__ unsigned xb_add(unsigned* p, unsigned v) { return __hip_atomic_fetch_add(p, v, __ATOMIC_RELAXED, __HIP_MEMORY_SCOPE_AGENT); }
__device__ __forceinline__ unsigned xb_xcc_id() { return (unsigned)__builtin_amdgcn_s_getreg((3 << 11) | 20) & 0xFu; }
#define XB_SPIN(cond, bar) do { unsigned _sp = 0; while (cond) { __builtin_amdgcn_s_sleep(1); \
    if ((++_sp & 255u) == 0u) { if (xb_ld(&(bar)[XB_TMO])) break; if (_sp > XB_SPIN_CAP) { atomicAdd(&(bar)[XB_TMO], 1u); break; } } } } while (0)

struct XcdBarrier {
    unsigned* bar; unsigned x;
    volatile LAS unsigned* st;
};

__device__ __forceinline__ XcdBarrier xcd_barrier_post(unsigned* bar, volatile LAS unsigned* st) {
    XcdBarrier b; b.bar = bar; b.x = xb_xcc_id(); b.st = st;
    if (threadIdx.x == 0) (void)xb_add(&bar[XB_XCNT(b.x)], 1u);
    return b;
}
__device__ __forceinline__ void xcd_barrier_complete(unsigned* bar, unsigned x, unsigned& nloc, unsigned& nx) {
    const unsigned G = gridDim.x * gridDim.y * gridDim.z;
    unsigned sum, cnt, mine, sp = 0u;
    for (;;) {
        sum = 0u; cnt = 0u; mine = 0u;
#pragma unroll
        for (unsigned j = 0; j < 16; ++j) { const unsigned c = xb_ld(&bar[XB_XCNT(j)]); sum += c; cnt += (c > 0u) ? 1u : 0u; mine = (j == x) ? c : mine; }
        if (sum == G) break;
        __builtin_amdgcn_s_sleep(1);
        if ((++sp & 255u) == 0u) { if (xb_ld(&bar[XB_TMO])) break; if (sp > XB_SPIN_CAP) { atomicAdd(&bar[XB_TMO], 1u); break; } }
    }
    nloc = mine > 0u ? mine : 1u; nx = cnt > 0u ? cnt : 1u;
}

__device__ __forceinline__ void xcd_barrier_leader(const XcdBarrier& b) {
    unsigned* bar = b.bar;
    __builtin_amdgcn_s_waitcnt(0);
    unsigned nloc = b.st[0], nx = b.st[1];
    if (nloc == 0u) { xcd_barrier_complete(bar, b.x, nloc, nx); b.st[0] = nloc; b.st[1] = nx; }
    const unsigned old = xb_add(&bar[XB_XSUB(b.x)], 1u);
    const unsigned gen = old / nloc;
    if (old + 1u == (gen + 1u) * nloc) {
        __builtin_amdgcn_fence(__ATOMIC_RELEASE, "agent");
        asm volatile("s_waitcnt vmcnt(0)" ::: "memory");
        const unsigned og = xb_add(&bar[XB_TOP], 1u);
        const unsigned tg = og / nx;
        if (og + 1u == (tg + 1u) * nx) xb_add(&bar[XB_TOPGEN], 1u);
        else XB_SPIN(xb_ld(&bar[XB_TOPGEN]) == tg, bar);
        __builtin_amdgcn_fence(__ATOMIC_ACQUIRE, "agent");
        xb_add(&bar[XB_XGEN(b.x)], 1u);
        asm volatile("s_waitcnt vmcnt(0)" ::: "memory");
    } else {
        XB_SPIN(xb_ld(&bar[XB_XGEN(b.x)]) == gen, bar);
        __builtin_amdgcn_fence(__ATOMIC_ACQUIRE, "agent");
        asm volatile("s_waitcnt vmcnt(0)" ::: "memory");
    }
}
__device__ __forceinline__ void xcd_barrier(const XcdBarrier& b) {
    asm volatile("s_waitcnt vmcnt(0)" ::: "memory");
    __syncthreads();
    if (threadIdx.x == 0) xcd_barrier_leader(b);
    __syncthreads();
}

#define XB_MISMATCH 3400
#define XB_GRP(g)   (XCD_BAR_WORDS + 32 * (g))
constexpr unsigned GRP_N = 4u;
#define XB_SIG(i)   (XCD_BAR_WORDS + 32 * 64 + 64 * (i))
__device__ __forceinline__ void xb_signal(const XcdBarrier& b, int i) {
    asm volatile("s_waitcnt vmcnt(0)" ::: "memory");
    __syncthreads();
    if (threadIdx.x == 0) { __builtin_amdgcn_fence(__ATOMIC_RELEASE, "agent"); asm volatile("s_waitcnt vmcnt(0)" ::: "memory"); (void)xb_add(&b.bar[XB_SIG(i)], 1u); }
}
__device__ __forceinline__ void xb_wait(const XcdBarrier& b, int i, unsigned n) {
    if (threadIdx.x == 0) { XB_SPIN(xb_ld(&b.bar[XB_SIG(i)]) < n, b.bar); __builtin_amdgcn_fence(__ATOMIC_ACQUIRE, "agent"); asm volatile("s_waitcnt vmcnt(0)" ::: "memory"); }
    __syncthreads();
}
__device__ __forceinline__ void grp_barrier(const XcdBarrier& b, int sig = -1, unsigned sig_n = 0u) {
    asm volatile("s_waitcnt vmcnt(0)" ::: "memory");
    __syncthreads();
    if (threadIdx.x == 0) {
        if (b.st[2] != 0u) {
            unsigned* cnt = &b.bar[XB_GRP(b.st[3] - 1u)];
            __builtin_amdgcn_s_waitcnt(0);
            const unsigned old = xb_add(cnt, 1u);
            const unsigned target = (old / GRP_N + 1u) * GRP_N;
            XB_SPIN(xb_ld(cnt) < target, b.bar);
            if (sig >= 0) XB_SPIN(xb_ld(&b.bar[XB_SIG(sig)]) < sig_n, b.bar);
            __builtin_amdgcn_fence(__ATOMIC_ACQUIRE, "agent");
            asm volatile("s_waitcnt vmcnt(0)" ::: "memory");
        } else xcd_barrier_leader(b);
    }
    __syncthreads();
}

struct Frame {
    LAS unsigned char* lds;
    volatile LAS unsigned* MISC;
    gu32* ctl;
    int tid, lane, wave, G;
    const float *x, *c, *norm_gain, *w_ada, *b_ada, *w_ffn_in, *w_ffn_out, *w_hgrn_in, *lb_logits, *hgain, *w_hgrn_out, *kv_gain, *w_ada_kv, *b_ada_kv, *w_kv, *b_kv, *w_q, *b_q, *sinks, *w_ao, *final_gain;
    float* out; unsigned char* ws;
};
__device__ __forceinline__ float wave_sum(float v) {
#pragma unroll
    for (int o = 1; o < 64; o <<= 1) v += __shfl_xor(v, o);
    return v;
}
__device__ __forceinline__ int frame_pm(const Frame& F) { return __builtin_amdgcn_readfirstlane((int)F.MISC[11]) - 1; }
__device__ __forceinline__ int frame_q(const Frame& F) { return __builtin_amdgcn_readfirstlane((int)F.MISC[12]); }
struct RowMap { int row0, stride, end; };
__device__ __forceinline__ RowMap norm_rows(const Frame& F) {
    RowMap r; const int pm = frame_pm(F), q = frame_q(F);
    if (pm >= 0) { r.row0 = pm * 256 + q * NWAVES + F.wave; r.stride = 4 * NWAVES; r.end = pm * 256 + 256; }
    else { r.row0 = blockIdx.x * NWAVES + F.wave; r.stride = F.G * NWAVES; r.end = M; }
    return r;
}
struct TItem { const float* W; bf16* WT; int K, N, item; bool ilv, blocked; };
__device__ __forceinline__ void p0_item_load(const TItem& T, float (&v)[32], int lane) {
    const int nblk = T.N / 32, kb = T.item / nblk, nb = T.item % nblk, k0 = 64 * kb, n0 = 32 * nb;
    const float* wp = T.W + (size_t)(k0 + (lane >> 5)) * T.N + n0 + (lane & 31);
#pragma unroll
    for (int i = 0; i < 32; ++i) v[i] = __builtin_nontemporal_load(wp + (size_t)(2 * i) * T.N);
}
__device__ __forceinline__ void p0_item_store(const TItem& T, const float (&v)[32], LAS float* scr, int lane) {
    const int nblk = T.N / 32, kb = T.item / nblk, nb = T.item % nblk, k0 = 64 * kb, n0 = 32 * nb;
    int drow0 = n0;
    if (T.ilv) { const int half = n0 >= DFF ? 1 : 0, j = n0 - half * DFF; drow0 = 256 * (j >> 7) + 128 * half + (j & 127); }
    const float wsc = T.ilv ? (n0 >= DFF ? -0.6931471805599453f : -1.4426950408889634f) : 1.0f;
#pragma unroll
    for (int i = 0; i < 32; ++i) scr[(2 * i + (lane >> 5)) * 33 + (lane & 31)] = v[i] * wsc;
    LDS_WAIT(); asm volatile("" ::: "memory");
    const int c = lane & 7;
#pragma unroll
    for (int j = 0; j < 4; ++j) { const int n = (lane >> 3) + 8 * j; const LAS float* s = scr + (8 * c) * 33 + n;
        v4u o; o.x = pk2(s[0 * 33], s[1 * 33]); o.y = pk2(s[2 * 33], s[3 * 33]); o.z = pk2(s[4 * 33], s[5 * 33]); o.w = pk2(s[6 * 33], s[7 * 33]);
        const size_t doff = T.blocked ? ((size_t)kb * T.N + drow0 + n) * 64 + 8 * c : (size_t)(drow0 + n) * T.K + k0 + 8 * c;
        *(GAS v4u*)(T.WT + doff) = o; }
    LDS_WAIT(); asm volatile("" ::: "memory");
}
constexpr int I_FI = (D / 64) * (NFF / 32), I_FO = (DFF / 64) * (D / 32), I_HI = (D / 64) * (4 * D / 32), I_DD = (D / 64) * (D / 32), I_KV = (D / 64) * (2 * KVD / 32);
constexpr int NITEMS = 4 * I_FI + 4 * I_FO + I_HI + 3 * I_DD + I_KV;
constexpr int DEF1_LO = 2 * I_FI, DEF1_HI = 4 * I_FI, DEF2_LO = 4 * I_FI + 1 * I_FO, DEF2_HI = 4 * I_FI + 4 * I_FO, DEF3_LO = 4 * I_FI + 4 * I_FO + I_HI + I_DD, DEF3_HI = DEF3_LO + 2 * I_DD;
constexpr int NDEF = (DEF1_HI - DEF1_LO) + (DEF2_HI - DEF2_LO) + (DEF3_HI - DEF3_LO), NITEMS_P0 = NITEMS - NDEF;
constexpr int DC1 = I_FO, DC2 = DC1 + I_FI, DC3 = DC2 + 2 * I_DD, DC4 = DC3 + I_FO, DC5 = DC4 + I_FI, DC6 = DC5 + I_FO;
static_assert(DC6 == NDEF, "deferred list");
constexpr int SLOT_A_LO = 0, SLOT_A_HI = 7000, SLOT_B_HI = 14000, SLOT_C_HI = DC3, SLOT_D_HI = DC4, SLOT_KV_LO = DC4, SLOT_KV_HI = DC6;
static_assert(SLOT_A_HI >= DC1 && SLOT_B_HI <= DC2 && SLOT_C_HI > SLOT_B_HI, "slot bounds: FFN-out[1] inside the first slot (needed by the second FFN), FFN-in[3] before W_q");
__device__ __forceinline__ int tr_p0_index(int d) {
    if (d >= DEF1_LO) d += DEF1_HI - DEF1_LO;
    if (d >= DEF2_LO) d += DEF2_HI - DEF2_LO;
    if (d >= DEF3_LO) d += DEF3_HI - DEF3_LO;
    return d;
}
__device__ __forceinline__ int tr_def_index(int e) {
    if (e < DC1) return 4 * I_FI + 1 * I_FO + e;
    if (e < DC2) return 3 * I_FI + (e - DC1);
    if (e < DC3) return DEF3_LO + (e - DC2);
    if (e < DC4) return 4 * I_FI + 3 * I_FO + (e - DC3);
    if (e < DC5) return 2 * I_FI + (e - DC4);
    return 4 * I_FI + 2 * I_FO + (e - DC5);
}
__device__ __forceinline__ void tr_decode(Frame& F, int it, TItem& T) {
    T.ilv = false; T.blocked = false; T.K = D; T.N = D; T.item = -1; T.W = nullptr; T.WT = nullptr;
    if (it < 0 || it >= NITEMS) return;
    if (it < 4 * I_FI) { const int f = it / I_FI; T.W = F.w_ffn_in + (size_t)f * D * NFF; T.WT = (bf16*)(F.ws + WS_WFI + f * SZ_WFI); T.K = D; T.N = NFF; T.ilv = true; T.item = it % I_FI; return; } it -= 4 * I_FI;
    if (it < 4 * I_FO) { const int f = it / I_FO; T.W = F.w_ffn_out + (size_t)f * DFF * D; T.WT = (bf16*)(F.ws + WS_WFO + f * SZ_WFO); T.K = DFF; T.N = D; T.blocked = true; T.item = it % I_FO; return; } it -= 4 * I_FO;
    if (it < I_HI) { T.W = F.w_hgrn_in; T.WT = (bf16*)(F.ws + WS_WHI); T.N = 4 * D; T.item = it; return; } it -= I_HI;
    if (it < I_DD) { T.W = F.w_hgrn_out; T.WT = (bf16*)(F.ws + WS_WHO); T.item = it; return; } it -= I_DD;
    if (it < I_DD) { T.W = F.w_q; T.WT = (bf16*)(F.ws + WS_WQ); T.item = it; return; } it -= I_DD;
    if (it < I_DD) { T.W = F.w_ao; T.WT = (bf16*)(F.ws + WS_WAO); T.item = it; return; } it -= I_DD;
    T.W = F.w_kv; T.WT = (bf16*)(F.ws + WS_WKV); T.N = 2 * KVD; T.item = it;
}
__device__ __forceinline__ void tr_deferred(Frame& F, int lo, int hi, int first_wg, int n_wg) {
    LAS float* scr = (LAS float*)(F.lds + F.wave * 8448);
    const int w = ((int)blockIdx.x - first_wg) * NWAVES + F.wave, NW = n_wg * NWAVES;
    TItem Tc, Tn; float vc[32], vn[32];
    int e = lo + w; bool have = e < hi;
    if (have) { tr_decode(F, tr_def_index(e), Tc); p0_item_load(Tc, vc, F.lane); }
    while (have) {
        const int en = e + NW; const bool hn = en < hi;
        if (hn) { tr_decode(F, tr_def_index(en), Tn); p0_item_load(Tn, vn, F.lane); }
        p0_item_store(Tc, vc, scr, F.lane);
        Tc = Tn; have = hn; e = en;
#pragma unroll
        for (int i = 0; i < 32; ++i) vc[i] = vn[i];
    }
}
__device__ __forceinline__ void p0_gemv_task(Frame& F, const float* W, const float* bias, float* outp, int N, int n0) {
    LAS float* cs = (LAS float*)(F.lds);
    LAS float* red = (LAS float*)(F.lds + 32768);
    f32x4 a0 = {0.f, 0.f, 0.f, 0.f}, a1 = a0, a2 = a0, a3 = a0;
    const float* wp = W + (size_t)(F.wave * 256) * N + n0 + 4 * F.lane;
#pragma unroll 16
    for (int k = 0; k < 256; ++k) { const f32x4 w = __builtin_nontemporal_load((const f32x4*)(wp + (size_t)k * N)); const int kk = F.wave * 256 + k;
        a0 += w * cs[kk]; a1 += w * cs[2048 + kk]; a2 += w * cs[4096 + kk]; a3 += w * cs[6144 + kk]; }
    LAS float* r = red + F.wave * 1024 + 4 * F.lane;
    *(LAS f32x4*)(r) = a0; *(LAS f32x4*)(r + 256) = a1; *(LAS f32x4*)(r + 512) = a2; *(LAS f32x4*)(r + 768) = a3;
    __syncthreads();
    for (int o = F.tid; o < 1024; o += NWAVES * 64) { float s = 0.f;
#pragma unroll
        for (int w = 0; w < 8; ++w) s += red[w * 1024 + o];
        const int b = o >> 8, n = n0 + (o & 255); outp[(size_t)b * N + n] = s + bias[n]; }
    __syncthreads();
}
__device__ __forceinline__ void p0_prologue(Frame& F, const XcdBarrier& bar, int sig_mod) {
    float* mod0 = (float*)(F.ws + WS_MOD0); float* mod1 = (float*)(F.ws + WS_MOD1); float* kvmod = (float*)(F.ws + WS_KVMOD);
    const int bx = blockIdx.x;
    for (int i = bx * 512 + F.tid; i < SEQ * 8; i += F.G * 512) { const int t = i >> 3, j = i & 7; const float inv = powf(500000.0f, -(float)(2 * j) / 16.0f); const float ang = (float)t * inv;
        ((float*)(F.ws + WS_SIN))[i] = (float)sin((double)ang); ((float*)(F.ws + WS_COS))[i] = (float)cos((double)ang); }
    for (int i = bx * 512 + F.tid; i < D; i += F.G * 512) { const float a = F.lb_logits[i], b = F.lb_logits[D + i], m = fmaxf(a, b), ea = expf(a - m), eb = expf(b - m); ((float*)(F.ws + WS_LB))[i] = ea / (ea + eb); }
    constexpr int NT0 = 9 * D / 256, NTK = 2 * D / 256, NGEMV = 2 * NT0 + NTK;
    if (bx < NGEMV) {
        LAS float* cs = (LAS float*)(F.lds);
        for (int i = F.tid; i < BATCH * D; i += NWAVES * 64) { const float v = F.c[i]; cs[i] = v / (1.f + expf(-v)); }
        __syncthreads();
        for (int task = bx; task < NGEMV; task += F.G) {
            if (task < NT0) p0_gemv_task(F, F.w_ada, F.b_ada, mod0, 9 * D, task * 256);
            else if (task < 2 * NT0) p0_gemv_task(F, F.w_ada + (size_t)D * 9 * D, F.b_ada + 9 * D, mod1, 9 * D, (task - NT0) * 256);
            else p0_gemv_task(F, F.w_ada_kv, F.b_ada_kv, kvmod, 2 * D, (task - 2 * NT0) * 256);
        }
    }
    xb_signal(bar, sig_mod);
    LAS float* scr = (LAS float*)(F.lds + F.wave * 8448);
    int pbase, pw, ptot;
    constexpr int SH_G = 6, SH_O = 13;
    if (F.G > NGEMV) { ptot = NGEMV * SH_G + (F.G - NGEMV) * SH_O; if (bx < NGEMV) { pbase = bx * SH_G; pw = SH_G; } else { pbase = NGEMV * SH_G + (bx - NGEMV) * SH_O; pw = SH_O; } }
    else { ptot = F.G; pbase = bx; pw = 1; }
    auto decode = [&](int q, TItem& T) -> bool {
        const int r = F.wave + NWAVES * (q / pw), p = q % pw; const int d = r * ptot + pbase + p;
        if (r * ptot >= NITEMS_P0) return false;
        tr_decode(F, d < NITEMS_P0 ? tr_p0_index(d) : -1, T);
        return true;
    };
    TItem Tc, Tn; float vc[32], vn[32];
    bool have = decode(0, Tc);
    if (have && Tc.item >= 0) p0_item_load(Tc, vc, F.lane);
    for (int q = 0; have; ++q) {
        const bool hn = decode(q + 1, Tn);
        if (hn && Tn.item >= 0) p0_item_load(Tn, vn, F.lane);
        if (Tc.item >= 0) p0_item_store(Tc, vc, scr, F.lane);
        Tc = Tn; have = hn;
#pragma unroll
        for (int i = 0; i < 32; ++i) vc[i] = vn[i];
    }
}
template <bool HSRC16, bool HDST16> __device__ __forceinline__ void norm_phase(Frame& F, const void* h, const bf16* y, void* hdst, const float* g1, const float* sh1, const float* sc1, int st1, bf16* o1,
                                           const float* g2, const float* sh2, const float* sc2, int st2, bf16* o2) {
    const RowMap rm = norm_rows(F); const int gw = rm.row0, NGW = rm.stride, MEND = rm.end;
    f32x4 a1[8], s1[8], a2[8], s2[8]; int bcur = -1;
    f32x4 hf[8]; v2u hh[8], yv[8];
#define NP_ISSUE(r_) do { if (HSRC16) { const GAS v2u* hr_ = (const GAS v2u*)((const bf16*)h + (size_t)(r_) * D) + F.lane; _Pragma("unroll") for (int j = 0; j < 8; ++j) hh[j] = __builtin_nontemporal_load(hr_ + 64 * j); } \
        else { const GAS f32x4* hr_ = (const GAS f32x4*)((const float*)h + (size_t)(r_) * D) + F.lane; _Pragma("unroll") for (int j = 0; j < 8; ++j) hf[j] = __builtin_nontemporal_load(hr_ + 64 * j); } \
        if (y) { const GAS v2u* yr_ = (const GAS v2u*)(y + (size_t)(r_) * D) + F.lane; _Pragma("unroll") for (int j = 0; j < 8; ++j) yv[j] = __builtin_nontemporal_load(yr_ + 64 * j); } } while (0)
    if (gw < MEND) NP_ISSUE(gw);
    for (int row = gw; row < MEND; row += NGW) {
        const int b = row / SEQ;
        f32x4 v[8]; float s = 0.f;
        if (HSRC16) {
#pragma unroll
            for (int j = 0; j < 8; ++j) { v[j].x = h2f((unsigned short)(hh[j].x & 0xffffu)); v[j].y = h2f((unsigned short)(hh[j].x >> 16)); v[j].z = h2f((unsigned short)(hh[j].y & 0xffffu)); v[j].w = h2f((unsigned short)(hh[j].y >> 16)); } }
        else {
#pragma unroll
            for (int j = 0; j < 8; ++j) v[j] = hf[j]; }
        if (y) {
#pragma unroll
            for (int j = 0; j < 8; ++j) { v[j].x += h2f((unsigned short)(yv[j].x & 0xffffu)); v[j].y += h2f((unsigned short)(yv[j].x >> 16)); v[j].z += h2f((unsigned short)(yv[j].y & 0xffffu)); v[j].w += h2f((unsigned short)(yv[j].y >> 16)); } }
        if (row + NGW < MEND) NP_ISSUE(row + NGW);
        if (y) {
            if (HDST16) { GAS v2u* hw = (GAS v2u*)((bf16*)hdst + (size_t)row * D) + F.lane;
#pragma unroll
                for (int j = 0; j < 8; ++j) { v2u w; w.x = pkh(v[j].x, v[j].y); w.y = pkh(v[j].z, v[j].w); __builtin_nontemporal_store(w, hw + 64 * j); } }
            else { GAS f32x4* hw = (GAS f32x4*)((float*)hdst + (size_t)row * D) + F.lane;
#pragma unroll
                for (int j = 0; j < 8; ++j) hw[64 * j] = v[j]; } }
        if (b != bcur) { bcur = b;
            const GAS f32x4* gp = (const GAS f32x4*)g1 + F.lane; const GAS f32x4* sp = (const GAS f32x4*)(sh1 + (size_t)b * st1) + F.lane; const GAS f32x4* cp = (const GAS f32x4*)(sc1 + (size_t)b * st1) + F.lane;
#pragma unroll
            for (int j = 0; j < 8; ++j) { a1[j] = gp[64 * j] * (cp[64 * j] + 1.0f); s1[j] = sp[64 * j]; }
            if (o2) { const GAS f32x4* gq = (const GAS f32x4*)g2 + F.lane; const GAS f32x4* sq = (const GAS f32x4*)(sh2 + (size_t)b * st2) + F.lane; const GAS f32x4* cq = (const GAS f32x4*)(sc2 + (size_t)b * st2) + F.lane;
#pragma unroll
                for (int j = 0; j < 8; ++j) { a2[j] = gq[64 * j] * (cq[64 * j] + 1.0f); s2[j] = sq[64 * j]; } }
        }
#pragma unroll
        for (int j = 0; j < 8; ++j) s += (v[j].x * v[j].x + v[j].y * v[j].y) + (v[j].z * v[j].z + v[j].w * v[j].w);
        const float rstd = 1.0f / sqrtf(wave_sum(s) * (1.f / D) + EPS);
        {   GAS v2u* op = (GAS v2u*)(o1 + (size_t)row * D) + F.lane;
#pragma unroll
            for (int j = 0; j < 8; ++j) { const f32x4 y_ = (v[j] * rstd) * a1[j] + s1[j]; v2u w; w.x = pk2(y_.x, y_.y); w.y = pk2(y_.z, y_.w); op[64 * j] = w; } }
        if (o2) { GAS v2u* op = (GAS v2u*)(o2 + (size_t)row * D) + F.lane;
#pragma unroll
            for (int j = 0; j < 8; ++j) { const f32x4 y_ = (v[j] * rstd) * a2[j] + s2[j]; v2u w; w.x = pk2(y_.x, y_.y); w.y = pk2(y_.z, y_.w); op[64 * j] = w; } }
    }
#undef NP_ISSUE
}
__device__ __forceinline__ void sw_phase(Frame& F) {
    constexpr int R1 = 4 * D, R2 = R1 + NFF, R3 = R2 + 2 * KVD, R4 = R3 + NFF, R5 = R4 + D, NR = R5 + NFF;
    const int gw = blockIdx.x * NWAVES + F.wave, NGW = F.G * NWAVES, per = (NR + NGW - 1) / NGW;
    const int r0 = gw * per, r1 = (r0 + per < NR) ? r0 + per : NR;
    float* SW = (float*)(F.ws + WS_SW);
    const float* mod0 = (const float*)(F.ws + WS_MOD0); const float* mod1 = (const float*)(F.ws + WS_MOD1); const float* kvmod = (const float*)(F.ws + WS_KVMOD);
    f32x4 sh[4][4][2]; int ccur = -1;
    for (int R = r0; R < r1; ++R) {
        int cons, n, N; const bf16* W; const float* shp; int shst; float* outp;
        if (R < R1) { cons = 0; n = R; N = 4 * D; W = (const bf16*)(F.ws + WS_WHI); shp = mod0 + 3 * D; shst = 9 * D; outp = SW + SWO_HI; }
        else if (R < R2) { cons = 1; n = R - R1; N = NFF; W = (const bf16*)(F.ws + WS_WFI + 1 * SZ_WFI); shp = mod0 + 6 * D; shst = 9 * D; outp = SW + SWO_F1; }
        else if (R < R3) { cons = 2; n = R - R2; N = 2 * KVD; W = (const bf16*)(F.ws + WS_WKV); shp = kvmod; shst = 2 * D; outp = SW + SWO_KV; }
        else if (R < R4) { cons = 3; n = R - R3; N = NFF; W = (const bf16*)(F.ws + WS_WFI + 2 * SZ_WFI); shp = mod1; shst = 9 * D; outp = SW + SWO_F2; }
        else if (R < R5) { cons = 4; n = R - R4; N = D; W = (const bf16*)(F.ws + WS_WQ); shp = mod1 + 3 * D; shst = 9 * D; outp = SW + SWO_Q; }
        else { cons = 5; n = R - R5; N = NFF; W = (const bf16*)(F.ws + WS_WFI + 3 * SZ_WFI); shp = mod1 + 6 * D; shst = 9 * D; outp = SW + SWO_F3; }
        const v4u* wr = (const v4u*)(W + (size_t)n * D) + F.lane;
        v4u wv[4];
#pragma unroll
        for (int j = 0; j < 4; ++j) wv[j] = wr[64 * j];
        if (cons != ccur) { ccur = cons;
#pragma unroll
            for (int b = 0; b < 4; ++b)
#pragma unroll
                for (int j = 0; j < 4; ++j) { const f32x4* sp = (const f32x4*)(shp + (size_t)b * shst + 8 * F.lane + 512 * j); sh[b][j][0] = sp[0]; sh[b][j][1] = sp[1]; } }
        float a[4] = {0.f, 0.f, 0.f, 0.f};
#pragma unroll
        for (int j = 0; j < 4; ++j) { const float w0 = bf2f((unsigned short)(wv[j].x & 0xffffu)), w1 = bf2f((unsigned short)(wv[j].x >> 16)), w2 = bf2f((unsigned short)(wv[j].y & 0xffffu)), w3 = bf2f((unsigned short)(wv[j].y >> 16)),
                w4 = bf2f((unsigned short)(wv[j].z & 0xffffu)), w5 = bf2f((unsigned short)(wv[j].z >> 16)), w6 = bf2f((unsigned short)(wv[j].w & 0xffffu)), w7 = bf2f((unsigned short)(wv[j].w >> 16));
#pragma unroll
            for (int b = 0; b < 4; ++b) { const f32x4 s0 = sh[b][j][0], s1 = sh[b][j][1]; a[b] += (w0 * s0.x + w1 * s0.y) + (w2 * s0.z + w3 * s0.w) + (w4 * s1.x + w5 * s1.y) + (w6 * s1.z + w7 * s1.w); } }
#pragma unroll
        for (int b = 0; b < 4; ++b) { const float t = wave_sum(a[b]); if (F.lane == 0) outp[(size_t)b * N + n] = t; }
    }
}
template <bool HSRC16> __device__ __forceinline__ void final_norm_phase(Frame& F, float* h, const bf16* h16, const bf16* y, const float* g) {
    const RowMap rm = norm_rows(F); const int gw = rm.row0, NGW = rm.stride, MEND = rm.end;
    f32x4 gv[8]; { const GAS f32x4* gp = (const GAS f32x4*)g + F.lane;
#pragma unroll
        for (int j = 0; j < 8; ++j) gv[j] = gp[64 * j]; }
    f32x4 hf[8]; v2u hh[8], yv[8];
#define FN_ISSUE(r_) do { if (HSRC16) { const GAS v2u* h6_ = (const GAS v2u*)(h16 + (size_t)(r_) * D) + F.lane; _Pragma("unroll") for (int j = 0; j < 8; ++j) hh[j] = __builtin_nontemporal_load(h6_ + 64 * j); } \
        else { const GAS f32x4* hr_ = (const GAS f32x4*)(h + (size_t)(r_) * D) + F.lane; _Pragma("unroll") for (int j = 0; j < 8; ++j) hf[j] = hr_[64 * j]; } \
        if (y) { const GAS v2u* yr_ = (const GAS v2u*)(y + (size_t)(r_) * D) + F.lane; _Pragma("unroll") for (int j = 0; j < 8; ++j) yv[j] = __builtin_nontemporal_load(yr_ + 64 * j); } } while (0)
    if (gw < MEND) FN_ISSUE(gw);
    for (int row = gw; row < MEND; row += NGW) {
        f32x4 v[8]; float s = 0.f;
        if (HSRC16) {
#pragma unroll
            for (int j = 0; j < 8; ++j) { v[j].x = h2f((unsigned short)(hh[j].x & 0xffffu)); v[j].y = h2f((unsigned short)(hh[j].x >> 16)); v[j].z = h2f((unsigned short)(hh[j].y & 0xffffu)); v[j].w = h2f((unsigned short)(hh[j].y >> 16)); } }
        else {
#pragma unroll
            for (int j = 0; j < 8; ++j) v[j] = hf[j]; }
#pragma unroll
        for (int j = 0; j < 8; ++j) { if (y) { v[j].x += h2f((unsigned short)(yv[j].x & 0xffffu)); v[j].y += h2f((unsigned short)(yv[j].x >> 16)); v[j].z += h2f((unsigned short)(yv[j].y & 0xffffu)); v[j].w += h2f((unsigned short)(yv[j].y >> 16)); }
            s += (v[j].x * v[j].x + v[j].y * v[j].y) + (v[j].z * v[j].z + v[j].w * v[j].w); }
        if (row + NGW < MEND) FN_ISSUE(row + NGW);
        const float rstd = 1.0f / sqrtf(wave_sum(s) * (1.f / D) + EPS);
        GAS f32x4* hw = (GAS f32x4*)(h + (size_t)row * D) + F.lane;
#pragma unroll
        for (int j = 0; j < 8; ++j) __builtin_nontemporal_store((v[j] * rstd) * gv[j], hw + 64 * j);
    }
#undef FN_ISSUE
}

namespace hg {
typedef short bf16x8 __attribute__((ext_vector_type(8)));
typedef short s16x4 __attribute__((ext_vector_type(4)));
typedef float f32x16 __attribute__((ext_vector_type(16)));
typedef float f32x2_t __attribute__((ext_vector_type(2))); typedef __bf16 bf16x2_t __attribute__((ext_vector_type(2)));
__device__ __forceinline__ unsigned cvtpk(float lo, float hi) { f32x2_t v = {lo, hi}; bf16x2_t b = __builtin_convertvector(v, bf16x2_t); return __builtin_bit_cast(unsigned, b); }
__device__ __forceinline__ s16x4 vtr(const LAS unsigned char* p) { return __builtin_bit_cast(s16x4, __builtin_amdgcn_ds_read_tr16_b64_v4i16((LAS s16x4*)p)); }
#define HG_MFMA(a, b, c) __builtin_amdgcn_mfma_f32_32x32x16_bf16((a), (b), (c), 0, 0, 0)
#define HG_BAR() do { asm volatile("s_waitcnt lgkmcnt(0)" ::: "memory"); __builtin_amdgcn_s_barrier(); asm volatile("" ::: "memory"); } while (0)
constexpr int CH = 32, SEGT = 512, NSEG = SEQ / SEGT, NCH = SEGT / CH, NUNIT = BATCH * HH * NSEG, NPAIR = NUNIT / 2;
constexpr int QT_ST = 272, KH_ST = 80, V_ST = 320, OUT_ST = 528;
constexpr int OFF_QT = 0, OFF_KT = OFF_QT + 32 * QT_ST, OFF_KH = OFF_KT + 32 * QT_ST, OFF_V = OFF_KH + 128 * KH_ST, OFF_OUT = OFF_V + 32 * V_ST, OFF_PL = OFF_OUT + 32 * OUT_ST, OFF_RK = OFF_PL + 512, OFF_RQ = OFF_RK + 32 * QT_ST, OFF_HG = OFF_RQ + 32 * QT_ST, GRP_BYTES = OFF_HG + 512;
static_assert(2 * GRP_BYTES <= RING_BYTES && OFF_KT % 16 == 0 && OFF_KH % 16 == 0 && OFF_V % 16 == 0 && OFF_OUT % 16 == 0 && OFF_PL % 16 == 0 && OFF_RK % 16 == 0 && OFF_RQ % 16 == 0 && GRP_BYTES % 16 == 0, "hgrn LDS map");

struct Raw { v4u vp[2]; v4u gp[2]; };
struct RawKQ { v4u kp[2]; v4u qp[2]; };
template <bool OUT> __device__ __forceinline__ void load_raw(Raw& R, const unsigned short* X, int c, int gt) {
#pragma unroll
    for (int j = 0; j < 2; ++j) { const int p = gt + 256 * j, s = p >> 4, c16 = p & 15; R.vp[j] = *(const GAS v4u*)(X + (size_t)(32 * c + s) * 8192 + 4096 + 8 * c16); }
    if (OUT) { const int trow = gt >> 3, vg = gt & 7;
#pragma unroll
        for (int j = 0; j < 2; ++j) R.gp[j] = *(const GAS v4u*)(X + (size_t)(32 * c + trow) * 8192 + 6144 + 16 * vg + 8 * j); }
}
template <bool OUT> __device__ __forceinline__ void load_kq(RawKQ& R, const unsigned short* X, int c, int gt) {
#pragma unroll
    for (int j = 0; j < 2; ++j) { const int p = gt + 256 * j, s = p >> 4, c16 = p & 15; const unsigned short* xp = X + (size_t)(32 * c + s) * 8192 + 8 * c16;
        R.kp[j] = *(const GAS v4u*)(xp + 2048); if (OUT) R.qp[j] = *(const GAS v4u*)xp; }
}
template <bool OUT> __device__ __forceinline__ void store_kq(const RawKQ& R, LAS unsigned char* L, int gt) {
#pragma unroll
    for (int j = 0; j < 2; ++j) { const int p = gt + 256 * j, s = p >> 4, c16 = p & 15;
        *(LAS v4u*)(L + OFF_RK + s * QT_ST + 16 * c16) = R.kp[j]; if (OUT) *(LAS v4u*)(L + OFF_RQ + s * QT_ST + 16 * c16) = R.qp[j]; }
}

template <bool OUT> __device__ __forceinline__ void hgrn_pair(Frame& F, int pair, const unsigned short* QKVG, float* HS, float* HDp, unsigned short* OG) {
    const int grp = F.wave >> 2, vt = F.wave & 3, gt = F.tid & 255, lane = F.lane, l31 = lane & 31, h = lane >> 5;
    const int unit = 2 * pair + grp, seg = unit % NSEG, bh = unit / NSEG, b = bh / HH, hh = bh % HH;
    LAS unsigned char* L = F.lds + RING_OFF + grp * GRP_BYTES;
    const unsigned short* X = QKVG + (size_t)(b * SEQ + seg * SEGT) * 8192 + hh * HK;
    const int pk = gt >> 1, ph = gt & 1;
    f32x16 S[4];
#pragma unroll
    for (int kt = 0; kt < 4; ++kt)
#pragma unroll
        for (int r = 0; r < 16; ++r) S[kt][r] = 0.f;
    Raw rA, rB; RawKQ pA, pB;
    load_kq<OUT>(pA, X, 0, gt); load_raw<OUT>(rA, X, 0, gt);
    if (OUT) {
        for (int j = 0; j < seg; ++j) {
            const int uj = bh * NSEG + j;
            const float* Uj = HS + (size_t)((uj * 4 + vt) * 4) * 1024 + lane * 16;
            const float* Dj = HDp + (size_t)uj * 128 + 4 * h;
#pragma unroll
            for (int kt = 0; kt < 4; ++kt)
#pragma unroll
                for (int g = 0; g < 4; ++g) { const f32x4 u4 = *(const GAS f32x4*)(Uj + kt * 1024 + 4 * g); const f32x4 d4 = *(const GAS f32x4*)(Dj + 32 * kt + 8 * g);
#pragma unroll
                    for (int e = 0; e < 4; ++e) S[kt][4 * g + e] = d4[e] * S[kt][4 * g + e] + u4[e]; }
        }
    }
    float Dtot = 1.f;
    const int trow = gt >> 3, vg = gt & 7;
    if (OUT) { if (gt < 128) *(LAS float*)(L + OFF_HG + 4 * gt) = *(const GAS float*)(F.hgain + hh * HK + gt); }
    store_kq<OUT>(pA, L, gt);
    load_kq<OUT>(pA, X, 1, gt);
    HG_BAR();
    auto chunk = [&](const int c, Raw& cur, Raw& nxt, RawKQ& P1, RawKQ& P2) __attribute__((always_inline)) {
        if (c + 2 < NCH) load_kq<OUT>(P2, X, c + 2, gt);
        if (c + 1 < NCH) load_raw<OUT>(nxt, X, c + 1, gt);
        float kk[16], P[16]; float run = 1.f;
#pragma unroll
        for (int i = 0; i < 16; ++i) { kk[i] = (float)__builtin_bit_cast(_Float16, *(const LAS unsigned short*)(L + OFF_RK + (16 * ph + i) * QT_ST + 2 * pk)); run *= (1.f - kk[i]); P[i] = run; }
        const float oth = __shfl_xor(run, 1);
        const float Pprev = ph ? oth : 1.f, Plast = run * oth;
        if (ph == 0) *(LAS float*)(L + OFF_PL + 4 * pk) = Plast;
        Dtot *= Plast;
        float kh[16];
#pragma unroll
        for (int i = 0; i < 16; ++i) { const float p = P[i] * Pprev; const float rp = __builtin_amdgcn_rcpf(fmaxf(p, 1e-30f)); const float ktl = kk[i] * rp; kh[i] = ktl * Plast;
            if (OUT) { *(LAS unsigned short*)(L + OFF_KT + (16 * ph + i) * QT_ST + 2 * pk) = (unsigned short)cvtpk(ktl, 0.f);
                       *(LAS unsigned short*)(L + OFF_QT + (16 * ph + i) * QT_ST + 2 * pk) = (unsigned short)cvtpk(bf2f(*(const LAS unsigned short*)(L + OFF_RQ + (16 * ph + i) * QT_ST + 2 * pk)) * p, 0.f); } }
        { v4u w0, w1; w0.x = cvtpk(kh[0], kh[1]); w0.y = cvtpk(kh[2], kh[3]); w0.z = cvtpk(kh[4], kh[5]); w0.w = cvtpk(kh[6], kh[7]);
          w1.x = cvtpk(kh[8], kh[9]); w1.y = cvtpk(kh[10], kh[11]); w1.z = cvtpk(kh[12], kh[13]); w1.w = cvtpk(kh[14], kh[15]);
          *(LAS v4u*)(L + OFF_KH + pk * KH_ST + 32 * ph) = w0; *(LAS v4u*)(L + OFF_KH + pk * KH_ST + 32 * ph + 16) = w1; }
#pragma unroll
        for (int j = 0; j < 2; ++j) { const int p = gt + 256 * j, s = p >> 4, c16 = p & 15; *(LAS v4u*)(L + OFF_V + s * V_ST + 16 * c16) = cur.vp[j]; }
        HG_BAR();
        if (c + 1 < NCH) store_kq<OUT>(P1, L, gt);
        f32x16 o;
        if (OUT) {
            f32x16 x;
#pragma unroll
            for (int r = 0; r < 16; ++r) { x[r] = 0.f; o[r] = 0.f; }
#pragma unroll
            for (int ks = 0; ks < 8; ++ks) { const bf16x8 a = *(const LAS bf16x8*)(L + OFF_KT + l31 * QT_ST + 32 * ks + 16 * h); const bf16x8 bq = *(const LAS bf16x8*)(L + OFF_QT + l31 * QT_ST + 32 * ks + 16 * h);
                x = HG_MFMA(a, bq, x); }
#pragma unroll
            for (int r = 0; r < 16; ++r) { const int s = (r & 3) + 8 * (r >> 2) + 4 * h; x[r] = (s <= l31) ? x[r] : 0.f; }
#pragma unroll
            for (int ks2 = 0; ks2 < 2; ++ks2) {
                v4u xp; xp.x = cvtpk(x[8 * ks2 + 0], x[8 * ks2 + 1]); xp.y = cvtpk(x[8 * ks2 + 2], x[8 * ks2 + 3]); xp.z = cvtpk(x[8 * ks2 + 4], x[8 * ks2 + 5]); xp.w = cvtpk(x[8 * ks2 + 6], x[8 * ks2 + 7]);
                const LAS unsigned char* vb = L + OFF_V + (16 * ks2 + 4 * h + ((lane >> 2) & 3)) * V_ST + 2 * (32 * vt + 16 * ((lane >> 4) & 1) + 4 * (lane & 3));
                const s16x4 lo = vtr(vb), hi = vtr(vb + 8 * V_ST);
                const bf16x8 vfrag = __builtin_shufflevector(lo, hi, 0, 1, 2, 3, 4, 5, 6, 7);
                o = HG_MFMA(__builtin_bit_cast(bf16x8, xp), vfrag, o); }
#pragma unroll
            for (int kt = 0; kt < 4; ++kt)
#pragma unroll
                for (int ks2 = 0; ks2 < 2; ++ks2) {
                    v4u sp; sp.x = cvtpk(S[kt][8 * ks2 + 0], S[kt][8 * ks2 + 1]); sp.y = cvtpk(S[kt][8 * ks2 + 2], S[kt][8 * ks2 + 3]); sp.z = cvtpk(S[kt][8 * ks2 + 4], S[kt][8 * ks2 + 5]); sp.w = cvtpk(S[kt][8 * ks2 + 6], S[kt][8 * ks2 + 7]);
                    const LAS unsigned char* qb = L + OFF_QT + l31 * QT_ST + 2 * (32 * kt + 16 * ks2 + 4 * h);
                    const s16x4 lo = *(const LAS s16x4*)qb, hi = *(const LAS s16x4*)(qb + 16);
                    const bf16x8 qfrag = __builtin_shufflevector(lo, hi, 0, 1, 2, 3, 4, 5, 6, 7);
                    o = HG_MFMA(qfrag, __builtin_bit_cast(bf16x8, sp), o); }
        }
        {   bf16x8 vfr[2];
#pragma unroll
            for (int ks2 = 0; ks2 < 2; ++ks2) { const LAS unsigned char* vb = L + OFF_V + (16 * ks2 + 8 * h + ((lane >> 2) & 3)) * V_ST + 2 * (32 * vt + 16 * ((lane >> 4) & 1) + 4 * (lane & 3));
                const s16x4 lo = vtr(vb), hi = vtr(vb + 4 * V_ST); vfr[ks2] = __builtin_shufflevector(lo, hi, 0, 1, 2, 3, 4, 5, 6, 7); }
#pragma unroll
            for (int kt = 0; kt < 4; ++kt) {
#pragma unroll
                for (int g = 0; g < 4; ++g) { const f32x4 d4 = *(const LAS f32x4*)(L + OFF_PL + 4 * (32 * kt + 8 * g + 4 * h));
#pragma unroll
                    for (int e = 0; e < 4; ++e) S[kt][4 * g + e] *= d4[e]; }
#pragma unroll
                for (int ks2 = 0; ks2 < 2; ++ks2) { const bf16x8 a = *(const LAS bf16x8*)(L + OFF_KH + (32 * kt + l31) * KH_ST + 32 * ks2 + 16 * h); S[kt] = HG_MFMA(a, vfr[ks2], S[kt]); } }
        }
        if (OUT) {
#pragma unroll
            for (int r = 0; r < 16; ++r) { const int t = (r & 3) + 8 * (r >> 2) + 4 * h; *(LAS float*)(L + OFF_OUT + t * OUT_ST + 4 * (32 * vt + l31)) = o[r]; }
        }
        HG_BAR();
        if (OUT) {
            f32x4 ov[4]; float ss = 0.f;
#pragma unroll
            for (int e = 0; e < 4; ++e) { ov[e] = *(const LAS f32x4*)(L + OFF_OUT + trow * OUT_ST + 64 * vg + 16 * e); ss += (ov[e].x * ov[e].x + ov[e].y * ov[e].y) + (ov[e].z * ov[e].z + ov[e].w * ov[e].w); }
            ss += __shfl_xor(ss, 1); ss += __shfl_xor(ss, 2); ss += __shfl_xor(ss, 4);
            const float rstd = 1.0f / sqrtf(ss * (1.f / 128.f) + EPS);
            v4u w[2];
#pragma unroll
            for (int j = 0; j < 2; ++j) { const v4u gq = cur.gp[j]; const f32x4 a = ov[2 * j] * rstd * *(const LAS f32x4*)(L + OFF_HG + 64 * vg + 32 * j), bq = ov[2 * j + 1] * rstd * *(const LAS f32x4*)(L + OFF_HG + 64 * vg + 32 * j + 16);
                w[j].x = cvtpk(a.x * bf2f((unsigned short)(gq.x & 0xffffu)), a.y * bf2f((unsigned short)(gq.x >> 16))); w[j].y = cvtpk(a.z * bf2f((unsigned short)(gq.y & 0xffffu)), a.w * bf2f((unsigned short)(gq.y >> 16)));
                w[j].z = cvtpk(bq.x * bf2f((unsigned short)(gq.z & 0xffffu)), bq.y * bf2f((unsigned short)(gq.z >> 16))); w[j].w = cvtpk(bq.z * bf2f((unsigned short)(gq.w & 0xffffu)), bq.w * bf2f((unsigned short)(gq.w >> 16))); }
            unsigned short* op = OG + (size_t)(b * SEQ + seg * SEGT + 32 * c + trow) * D + hh * HK + 16 * vg;
            *(GAS v4u*)op = w[0]; *(GAS v4u*)(op + 8) = w[1];
        }
    };
#pragma unroll 1
    for (int c = 0; c < NCH; c += 2) { chunk(c, rA, rB, pA, pB); chunk(c + 1, rB, rA, pB, pA); }
    if (!OUT) {
        float* Uo = HS + (size_t)((unit * 4 + vt) * 4) * 1024 + lane * 16;
#pragma unroll
        for (int kt = 0; kt < 4; ++kt)
#pragma unroll
            for (int g = 0; g < 4; ++g) *(GAS f32x4*)(Uo + kt * 1024 + 4 * g) = (f32x4){S[kt][4 * g], S[kt][4 * g + 1], S[kt][4 * g + 2], S[kt][4 * g + 3]};
        if (ph == 0) *(GAS float*)(HDp + (size_t)unit * 128 + pk) = Dtot;
    }
}
template <bool OUT> __device__ __forceinline__ void hgrn_phase(Frame& F, const unsigned short* QKVG, float* HS, float* HDp, unsigned short* OG) {
    for (int pair = blockIdx.x; pair < NPAIR; pair += F.G) { hgrn_pair<OUT>(F, pair, QKVG, HS, HDp, OG); HG_BAR(); }
}
}

namespace at {
using hg::bf16x8; using hg::s16x4; using hg::f32x16; using hg::cvtpk; using hg::vtr;
constexpr int K_ST = 144, V_ST = 192;
template <int NQB> struct Lay { static constexpr int KEYS = (NQB + 1) * WIN, OFF_K = 0, OFF_V = KEYS * K_ST, BYTES = OFF_V + KEYS * V_ST; };
constexpr int NBLK = SEQ / WIN, NUNIT = BATCH * NBLK * NKV;
static_assert(Lay<2>::BYTES <= RING_BYTES && Lay<1>::OFF_V % 16 == 0 && Lay<2>::OFF_V % 16 == 0, "attention LDS map");
template <int NQB> __device__ __forceinline__ void attn_unit(Frame& F, int unit, const unsigned short* Q, const unsigned short* K, const unsigned short* V, unsigned short* O) {
    constexpr int OFF_K = Lay<NQB>::OFF_K, OFF_V = Lay<NQB>::OFF_V, KEYS = Lay<NQB>::KEYS;
    const int kvh = unit % NKV, n = (unit / NKV) % NBLK, b = unit / (NKV * NBLK);
    LAS unsigned char* L = F.lds + RING_OFF;
    const int lane = F.lane, l31 = lane & 31, h = lane >> 5;
    for (int p = F.tid; p < KEYS * 8; p += NWAVES * 64) { const int r = p >> 3, c8 = p & 7, srow = (n - 1) * WIN + r;
        v4u kv = {0u, 0u, 0u, 0u}, vv = {0u, 0u, 0u, 0u};
        if (srow >= 0) { const size_t go = (size_t)(b * SEQ + srow) * KVD + kvh * HD + 8 * c8; kv = *(const GAS v4u*)(K + go); vv = *(const GAS v4u*)(V + go); }
        *(LAS v4u*)(L + OFF_K + r * K_ST + 16 * c8) = kv; *(LAS v4u*)(L + OFF_V + r * V_ST + 16 * c8) = vv; }
    HG_BAR();
    const int qh = kvh * 8 + F.wave;
    const float sink2 = *(const GAS float*)(F.sinks + qh) * 1.4426950408889634f;
    const unsigned short* Qb = Q + (size_t)(b * SEQ + n * WIN + l31) * D + qh * HD + 8 * h;
    bf16x8 qn[4];
#pragma unroll
    for (int ks = 0; ks < 4; ++ks) qn[ks] = *(const GAS bf16x8*)(Qb + 16 * ks);
#pragma unroll 1
    for (int qt = 0; qt < 4 * NQB; ++qt) {
        bf16x8 qf[4];
#pragma unroll
        for (int ks = 0; ks < 4; ++ks) qf[ks] = qn[ks];
        if (qt < 4 * NQB - 1) {
#pragma unroll
            for (int ks = 0; ks < 4; ++ks) qn[ks] = *(const GAS bf16x8*)(Qb + (size_t)(32 * (qt + 1)) * D + 16 * ks); }
        f32x16 x[5];
#pragma unroll
        for (int i = 0; i < 5; ++i) {
#pragma unroll
            for (int r = 0; r < 16; ++r) x[i][r] = 0.f;
#pragma unroll
            for (int ks = 0; ks < 4; ++ks) { const bf16x8 a = *(const LAS bf16x8*)(L + OFF_K + (32 * (qt + i) + l31) * K_ST + 32 * ks + 16 * h); x[i] = HG_MFMA(a, qf[ks], x[i]); } }
        float mx = sink2;
        if (n == 0 && qt < 4) {
#pragma unroll
            for (int i = 0; i < 4; ++i)
#pragma unroll
                for (int r = 0; r < 16; ++r) { const int cr = (r & 3) + 8 * (r >> 2) + 4 * h; if (32 * (qt + i) + cr < WIN) x[i][r] = -INFINITY; }
        }
#pragma unroll
        for (int r = 0; r < 16; ++r) { const int cr = (r & 3) + 8 * (r >> 2) + 4 * h; x[0][r] = (cr > l31) ? x[0][r] : -INFINITY; x[4][r] = (cr <= l31) ? x[4][r] : -INFINITY; }
#pragma unroll
        for (int i = 0; i < 5; ++i)
#pragma unroll
            for (int r = 0; r < 16; ++r) mx = fmaxf(mx, x[i][r]);
        mx = fmaxf(mx, __shfl_xor(mx, 32));
        float sum = 0.f;
#pragma unroll
        for (int i = 0; i < 5; ++i)
#pragma unroll
            for (int r = 0; r < 16; ++r) { const float p = __builtin_amdgcn_exp2f(x[i][r] - mx); x[i][r] = p; sum += p; }
        sum += __shfl_xor(sum, 32);
        sum += __builtin_amdgcn_exp2f(sink2 - mx);
        const float inv = 1.0f / sum;
        f32x16 o[2];
#pragma unroll
        for (int r = 0; r < 16; ++r) { o[0][r] = 0.f; o[1][r] = 0.f; }
#pragma unroll
        for (int i = 0; i < 5; ++i)
#pragma unroll
            for (int ks2 = 0; ks2 < 2; ++ks2) {
                v4u pp; pp.x = cvtpk(x[i][8 * ks2 + 0], x[i][8 * ks2 + 1]); pp.y = cvtpk(x[i][8 * ks2 + 2], x[i][8 * ks2 + 3]);
                pp.z = cvtpk(x[i][8 * ks2 + 4], x[i][8 * ks2 + 5]); pp.w = cvtpk(x[i][8 * ks2 + 6], x[i][8 * ks2 + 7]);
#pragma unroll
                for (int dt = 0; dt < 2; ++dt) {
                    const LAS unsigned char* vb = L + OFF_V + (32 * (qt + i) + 16 * ks2 + 4 * h + ((lane >> 2) & 3)) * V_ST + 2 * (32 * dt + 16 * ((lane >> 4) & 1) + 4 * (lane & 3));
                    const s16x4 lo = vtr(vb), hi = vtr(vb + 8 * V_ST);
                    o[dt] = HG_MFMA(__builtin_shufflevector(lo, hi, 0, 1, 2, 3, 4, 5, 6, 7), __builtin_bit_cast(bf16x8, pp), o[dt]); } }
        unsigned short* orow = O + (size_t)(b * SEQ + n * WIN + 32 * qt + l31) * D + qh * HD + 4 * h;
#pragma unroll
        for (int dt = 0; dt < 2; ++dt)
#pragma unroll
            for (int g = 0; g < 4; ++g) { v2u w; w.x = cvtpk(o[dt][4 * g + 0] * inv, o[dt][4 * g + 1] * inv); w.y = cvtpk(o[dt][4 * g + 2] * inv, o[dt][4 * g + 3] * inv);
                *(GAS v2u*)(orow + 32 * dt + 8 * g) = w; }
    }
}
__device__ __forceinline__ void attn_phase(Frame& F, const unsigned short* Q, const unsigned short* K, const unsigned short* V, unsigned short* O) {
    const int pm_ = frame_pm(F);
    if (pm_ >= 0) {
        { const int b = pm_ / (SEQ / 256), n = 2 * (pm_ % (SEQ / 256)); attn_unit<2>(F, (b * NBLK + n) * NKV + frame_q(F), Q, K, V, O); HG_BAR(); }
        return; }
    for (int unit = blockIdx.x; unit < NUNIT; unit += F.G) { attn_unit<1>(F, unit, Q, K, V, O); HG_BAR(); }
}
}
constexpr int N_PHASES = 24;
constexpr int SIG_B = 0, SIG_KVC = 1, SIG_KVG = 2, SIG_C = 3, SIG_D = 4, SIG_MOD = 5;
constexpr int PROBE_K = -1, PROBE_N = 2;
#define REPK(k) ((k) == PROBE_K ? PROBE_N : 1)
struct Args { const float* in[21]; float* out; unsigned char* ws; int ph_lo, ph_hi, li, pad; };
__global__ void __launch_bounds__(NWAVES * 64, 2) mega_fwd(Args args) {
    extern __shared__ __attribute__((aligned(16))) unsigned char lds[];
    Frame F;
    F.lds = (LAS unsigned char*)lds; F.MISC = (volatile LAS unsigned*)(F.lds + MISC_OFF);
    F.tid = threadIdx.x; F.lane = F.tid & 63; F.wave = __builtin_amdgcn_readfirstlane(F.tid >> 6); F.G = gridDim.x;
    F.ws = args.ws; F.out = args.out; F.ctl = (gu32*)(args.ws + WS_CTL);
    F.x = args.in[0]; F.c = args.in[1]; F.norm_gain = args.in[2]; F.w_ada = args.in[3]; F.b_ada = args.in[4]; F.w_ffn_in = args.in[5]; F.w_ffn_out = args.in[6]; F.w_hgrn_in = args.in[7];
    F.lb_logits = args.in[8]; F.hgain = args.in[9]; F.w_hgrn_out = args.in[10]; F.kv_gain = args.in[11]; F.w_ada_kv = args.in[12]; F.b_ada_kv = args.in[13]; F.w_kv = args.in[14]; F.b_kv = args.in[15];
    F.w_q = args.in[16]; F.b_q = args.in[17]; F.sinks = args.in[18]; F.w_ao = args.in[19]; F.final_gain = args.in[20];
    for (int u = F.tid; u < (LDS_BYTES - LDSCTL_OFF) / 4; u += NWAVES * 64) ((LAS unsigned*)(F.lds + LDSCTL_OFF))[u] = 0u;
    __syncthreads();
    XcdBarrier bar = xcd_barrier_post((unsigned*)(F.ctl + CW_BAR) + args.li * XCD_BAR_WORDS, F.MISC + 8);
    if (threadIdx.x == 0 && F.G == 256 && args.pad == 1) { const unsigned c = blockIdx.x; F.MISC[11] = 1u + 8u * (c & 7u) + ((c >> 3) & 7u); F.MISC[12] = c >> 6; }
    __syncthreads();
    if (threadIdx.x == 0 && (F.G != 256 || args.pad != 1 || bar.x != (blockIdx.x & 7u))) (void)xb_add(&bar.bar[XB_MISMATCH], 1u);
    const int lo = args.ph_lo, hi = args.ph_hi;
#define IN(k) (lo <= (k) && (k) < hi)
#define SEAM(k) do { if (IN(k) && IN((k) + 1)) xcd_barrier(bar); } while (0)
#define SEAMS(k, sig, n) do { if (IN(k) && IN((k) + 1)) grp_barrier(bar, (sig), (n)); } while (0)
#define SEAML(k) do { if (IN(k) && IN((k) + 1)) grp_barrier(bar); } while (0)
#define REPEAT(n) _Pragma("nounroll") for (int _r = 0; _r < (n); ++_r, (_r < (n) ? xcd_barrier(bar) : (void)0))
#define mod0 ((const float*)(ws + WS_MOD0))
#define mod1 ((const float*)(ws + WS_MOD1))
#define kvmod ((const float*)(ws + WS_KVMOD))
#define U ((bf16*)(ws + WS_U))
#define UKV ((bf16*)(ws + WS_UKV))
#define HID ((bf16*)(ws + WS_HID))
#define QKVG ((bf16*)(ws + WS_QKVG))
#define OG ((bf16*)(ws + WS_OG))
#define QB ((bf16*)(ws + WS_Q))
#define KB ((bf16*)(ws + WS_K))
#define VB ((bf16*)(ws + WS_V))
#define sint ((const float*)(ws + WS_SIN))
#define cost ((const float*)(ws + WS_COS))
    constexpr int MS = 9 * D;
#define PH_BEGIN unsigned char* ws = args.ws; asm volatile("" : "+s"(ws)); { int _t = threadIdx.x; asm volatile("" : "+v"(_t)); F.tid = _t; F.lane = _t & 63; F.wave = __builtin_amdgcn_readfirstlane(_t >> 6); } int bx = __builtin_amdgcn_readfirstlane((int)blockIdx.x); asm volatile("" : "+s"(bx));
#define YB ((bf16*)(ws + WS_Y))
#define H16 ((bf16*)(ws + WS_H16))
constexpr bool RES16 = true;
#define NOFIX pg8::NormFix{nullptr, nullptr, 0, 0.f, 0.f}
#define FFN_IN(f) do { pg8::Gemm g{U, (const bf16*)(ws + WS_WFI + (f) * SZ_WFI), M, NFF, D, 2 * D, 128, 2 * D, 128, -1}; pg8::StaticOrder S; S.init(M, NFF, F.G, bx); pg8::EpiSwiGLU<false> E{HID, M, NOFIX}; \
        pg8::gemm_phase<pg8::EpiSwiGLU<false>, pg8::StaticOrder, true, true>(F.lds + RING_OFF, g, S, E); } while (0)
#define FFN_OUT(f, mod, sub) do { pg8::Gemm g{HID, (const bf16*)(ws + WS_WFO + (f) * SZ_WFO), M, D, DFF, 128, 128 * M, 128, 128 * D, -1}; pg8::StaticOrder S; S.init(M, D, F.G, bx); \
        pg8::EpiY<true> E{YB, D, (mod) + ((sub) * 3 + 2) * D, MS}; pg8::gemm_phase<pg8::EpiY<true>, pg8::StaticOrder, true, true>(F.lds + RING_OFF, g, S, E); } while (0)
#define FFN_OUT_R(f, mod, sub, SRC32_) do { pg8::Gemm g{HID, (const bf16*)(ws + WS_WFO + (f) * SZ_WFO), M, D, DFF, 128, 128 * M, 128, 128 * D, -1}; pg8::StaticOrder S; S.init(M, D, F.G, bx); \
        pg8::EpiYR<true, SRC32_> E{H16, F.x, D, (mod) + ((sub) * 3 + 2) * D, MS}; pg8::gemm_phase<pg8::EpiYR<true, SRC32_>, pg8::StaticOrder, true, true>(F.lds + RING_OFF, g, S, E); } while (0)
#define PROJ_OUT_R(A_, W_, mod) do { pg8::Gemm g{(A_), (const bf16*)(ws + (W_)), M, D, D, 2 * D, 128, 2 * D, 128, -1}; pg8::StaticOrder S; S.init(M, D, F.G, bx); \
        pg8::EpiYR<false, false> E{H16, F.x, D, (mod) + (1 * 3 + 2) * D, MS}; pg8::gemm_phase<pg8::EpiYR<false, false>, pg8::StaticOrder, true, true>(F.lds + RING_OFF, g, S, E); } while (0)
#define NORM16(layer, sub, mod) norm_phase<true, true>(F, (const void*)H16, nullptr, nullptr, F.norm_gain + (size_t)((layer) * 3 + (sub)) * D, (mod) + ((sub) * 3 + 0) * D, (mod) + ((sub) * 3 + 1) * D, MS, U, nullptr, nullptr, nullptr, 0, nullptr)
#define PROJ_OUT(A_, W_, mod) do { pg8::Gemm g{(A_), (const bf16*)(ws + (W_)), M, D, D, 2 * D, 128, 2 * D, 128, -1}; pg8::StaticOrder S; S.init(M, D, F.G, bx); \
        pg8::EpiY<false> E{YB, D, (mod) + (1 * 3 + 2) * D, MS}; pg8::gemm_phase<pg8::EpiY<false>, pg8::StaticOrder, true, true>(F.lds + RING_OFF, g, S, E); } while (0)
#define ADDNORM(S16, hsrc, layer, sub, mod) norm_phase<S16, RES16>(F, (hsrc), YB, RES16 ? (void*)H16 : (void*)F.out, F.norm_gain + (size_t)((layer) * 3 + (sub)) * D, (mod) + ((sub) * 3 + 0) * D, (mod) + ((sub) * 3 + 1) * D, MS, U, nullptr, nullptr, nullptr, 0, nullptr)

    if (IN(0)) { PH_BEGIN; p0_prologue(F, bar, SIG_MOD); }
    if (IN(0) && IN(1)) xb_wait(bar, SIG_MOD, (unsigned)F.G);
    if (IN(1)) { PH_BEGIN; if (F.G != 256) tr_deferred(F, 0, NDEF, 0, F.G);
        norm_phase<false, false>(F, F.x, nullptr, nullptr, F.norm_gain + 0 * D, mod0 + 0 * D, mod0 + 1 * D, MS, U, nullptr, nullptr, nullptr, 0, nullptr); }
    SEAM(1);
    if (IN(1) && IN(2) && threadIdx.x == 0) F.MISC[10] = (xb_ld(&bar.bar[XB_MISMATCH]) == 0u) ? 1u : 0u;
    if (IN(2)) { PH_BEGIN; FFN_IN(0); if (F.G == 256 && bx >= 192) tr_deferred(F, SLOT_A_LO, SLOT_A_HI, 192, 64); }
    SEAML(2);
    if (IN(3)) { PH_BEGIN; FFN_OUT_R(0, mod0, 0, true); }
    SEAML(3);
    if (IN(4)) { PH_BEGIN; NORM16(0, 1, mod0); }
    SEAML(4);
    if (IN(5)) { PH_BEGIN; { pg8::Gemm g{U, (const bf16*)(ws + WS_WHI), M, 4 * D, D, 2 * D, 128, 2 * D, 128, -1}; pg8::StaticOrder S; S.init(M, 4 * D, F.G, bx); pg8::EpiHgrn<false> E{QKVG, (const float*)(ws + WS_LB), NOFIX};
        pg8::gemm_phase<pg8::EpiHgrn<false>, pg8::StaticOrder, true, true>(F.lds + RING_OFF, g, S, E); } }
    SEAM(5);
    if (IN(6)) { PH_BEGIN; REPEAT(REPK(6)) hg::hgrn_phase<false>(F, QKVG, (float*)(ws + WS_HS), (float*)(ws + WS_HD), OG); }
    SEAM(6);
    if (IN(7)) { PH_BEGIN; REPEAT(REPK(7)) hg::hgrn_phase<true>(F, QKVG, (float*)(ws + WS_HS), (float*)(ws + WS_HD), OG); }
    SEAM(7);
    if (IN(8)) { PH_BEGIN; PROJ_OUT_R(OG, WS_WHO, mod0); }
    SEAML(8);
    if (IN(9)) { PH_BEGIN; NORM16(0, 2, mod0); }
    SEAML(9);
    if (IN(10)) { PH_BEGIN; FFN_IN(1); if (F.G == 256 && bx >= 192) { tr_deferred(F, SLOT_A_HI, SLOT_B_HI, 192, 64); xb_signal(bar, SIG_B); } }
    SEAML(10);
    if (IN(11)) { PH_BEGIN; FFN_OUT_R(1, mod0, 2, false); }
    SEAML(11);
    if (IN(12)) { PH_BEGIN; norm_phase<true, true>(F, (const void*)H16, nullptr, nullptr, F.norm_gain + (size_t)(1 * 3 + 0) * D, mod1 + 0 * D, mod1 + 1 * D, MS, U, F.kv_gain, kvmod, kvmod + D, 2 * D, UKV); }
    SEAML(12);
    if (IN(13)) { PH_BEGIN; { pg8::Gemm g{UKV, (const bf16*)(ws + WS_WKV), M, 2 * KVD, D, 2 * D, 128, 2 * D, 128, -1}; pg8::StaticOrder S; S.init(M, 2 * KVD, F.G, bx);
        pg8::EpiRope<false> E{KB, VB, KVD, KVD, F.b_kv, sint, cost, 1.0f, 1, NOFIX};
        pg8::gemm_phase<pg8::EpiRope<false>, pg8::StaticOrder, true, true>(F.lds + RING_OFF, g, S, E); }
        if (F.G == 256) { if (bx >= 128) { tr_deferred(F, SLOT_KV_LO, SLOT_KV_HI, 128, 128); xb_signal(bar, SIG_KVC); } else xb_signal(bar, SIG_KVG); } }
    SEAMS(13, SIG_KVC, 128u);
    if (IN(14)) { PH_BEGIN; FFN_IN(2); if (F.G == 256 && bx >= 192) { tr_deferred(F, SLOT_B_HI, SLOT_C_HI, 192, 64); xb_signal(bar, SIG_C); } }
    SEAML(14);
    if (IN(15)) { PH_BEGIN; FFN_OUT_R(2, mod1, 0, false); }
    SEAML(15);
    if (IN(16)) { PH_BEGIN; NORM16(1, 1, mod1); }
    SEAMS(16, SIG_C, 64u);
    if (IN(17)) { PH_BEGIN; { pg8::Gemm g{U, (const bf16*)(ws + WS_WQ), M, D, D, 2 * D, 128, 2 * D, 128, -1}; pg8::StaticOrder S; S.init(M, D, F.G, bx);
        pg8::EpiRope<false> E{QB, QB, 1 << 30, D, F.b_q, sint, cost, QSCALE, 1 << 30, NOFIX};
        pg8::gemm_phase<pg8::EpiRope<false>, pg8::StaticOrder, true, true>(F.lds + RING_OFF, g, S, E); } }
    SEAMS(17, SIG_KVG, 128u);
    if (IN(18)) { PH_BEGIN; REPEAT(REPK(18)) at::attn_phase(F, QB, KB, VB, OG); }
    SEAML(18);
    if (IN(19)) { PH_BEGIN; PROJ_OUT_R(OG, WS_WAO, mod1); }
    SEAML(19);
    if (IN(20)) { PH_BEGIN; NORM16(1, 2, mod1); }
    SEAMS(20, SIG_B, 64u);
    if (IN(21)) { PH_BEGIN; FFN_IN(3); if (F.G == 256 && bx >= 192) { tr_deferred(F, SLOT_C_HI, SLOT_D_HI, 192, 64); xb_signal(bar, SIG_D); } }
    SEAMS(21, SIG_D, 64u);
    if (IN(22)) { PH_BEGIN; FFN_OUT_R(3, mod1, 2, false); }
    SEAML(22);
    if (IN(23)) { PH_BEGIN; final_norm_phase<true>(F, F.out, H16, nullptr, F.final_gain); }
#undef IN
#undef SEAM
#undef SEAML
#undef SEAMS
#undef YB
#undef H16
#undef mod0
#undef mod1
#undef kvmod
#undef U
#undef UKV
#undef HID
#undef QKVG
#undef OG
#undef QB
#undef KB
#undef VB
#undef sint
#undef cost
}

extern "C" void kernel_launch(void* const* d_in, const int* in_sizes, int n_in, void* d_out, int out_size, void* d_ws, size_t ws_size, hipStream_t stream) {
    static int grid = 0;
    if (grid == 0) {
        if (n_in != 21 || in_sizes[0] != M * D || out_size != M * D || ws_size < WS_END) { fprintf(stderr, "kernel_launch: unexpected shapes (n_in %d, in0 %d, out %d, ws %zu < %zu)\n", n_in, n_in > 0 ? in_sizes[0] : -1, out_size, ws_size, (size_t)WS_END); grid = -1; return; }
        int dev = 0, cus = 0, per_cu = 0;
        if (hipGetDevice(&dev) != hipSuccess || hipDeviceGetAttribute(&cus, hipDeviceAttributeMultiprocessorCount, dev) != hipSuccess) { grid = -1; return; }
        if (hipFuncSetAttribute((const void*)mega_fwd, hipFuncAttributeMaxDynamicSharedMemorySize, LDS_BYTES) != hipSuccess) { fprintf(stderr, "kernel_launch: hipFuncSetAttribute failed\n"); grid = -1; return; }
        if (hipOccupancyMaxActiveBlocksPerMultiprocessor(&per_cu, (const void*)mega_fwd, NWAVES * 64, LDS_BYTES) != hipSuccess || per_cu < 1) fprintf(stderr, "kernel_launch: occupancy query reports %d\n", per_cu);
        (void)hipGetLastError();
        grid = cus;
    }
    if (grid < 0) return;
    if (hipMemsetAsync((char*)d_ws + WS_CTL, 0, CTL_ZERO_BYTES, stream) != hipSuccess) return;
    static int panel_ok = -1;
    if (panel_ok < 0) {
        panel_ok = (grid == 256) ? 1 : 0;
        const int shapes[4] = {NFF, D, 4 * D, 2 * KVD};
        for (int sI = 0; sI < 4 && panel_ok; ++sI) for (int c = 0; c < 256 && panel_ok; ++c) { pg8::StaticOrder S; S.init(M, shapes[sI], 256, c); pg8::Unit u;
            for (int i = 0; S.next(i, u); ++i) if (u.pm != 8 * (c & 7) + ((c >> 3) & 7)) { panel_ok = 0; break; } }
    }
    Args a{};
    a.pad = panel_ok;
    for (int i = 0; i < 21; ++i) a.in[i] = (const float*)d_in[i];
    a.out = (float*)d_out; a.ws = (unsigned char*)d_ws;
    auto launch = [&](int lo, int hi, int li) { a.ph_lo = lo; a.ph_hi = hi; a.li = li; hipLaunchKernelGGL(mega_fwd, dim3(grid), dim3(NWAVES * 64), LDS_BYTES, stream, a); };
    launch(0, N_PHASES, 0);
}
```
